# Optimizing an MI355X kernel written in HIP

```python
import jax, jax.numpy as jnp
from jax import lax
import numpy as np

D_MODEL = 1024
BATCH = 16
SEQ = 4096
DEPTH = 1

EPS = 1e-6
NSA_HEADS = 8
NSA_KV_GROUPS = 2
NSA_REP = NSA_HEADS // NSA_KV_GROUPS
HEAD_DIM = 64
NSA_WIDTH = NSA_HEADS * HEAD_DIM
KV_WIDTH = NSA_KV_GROUPS * HEAD_DIM
CMP_STRIDE = 16
CMP_BLOCK = 2 * CMP_STRIDE
CMP_HIDDEN = 256
SEL_BLOCK = 64
SEL_TOP_N = 16
SEL_Q_BLOCK = 64
WINDOW = 512
WIN_Q_BLOCK = 128
ROPE_DIM = HEAD_DIM // 4
ROPE_THETA = 500000.0
SSD_HEADS = 8
SSD_HEAD_DIM = 64
SSD_WIDTH = SSD_HEADS * SSD_HEAD_DIM
SSD_GROUPS = 2
SSD_REP = SSD_HEADS // SSD_GROUPS
SSD_STATE = 128
SSD_CONV = 4
SSD_CHUNK = 128
SSD_CONV_DIM = SSD_WIDTH + 2 * SSD_GROUPS * SSD_STATE
MIX_WIDTH = NSA_WIDTH + SSD_WIDTH
IN_PROJ = NSA_WIDTH + 6 * KV_WIDTH + 3 * NSA_HEADS + SSD_WIDTH + SSD_CONV_DIM + SSD_HEADS
PEER_HEADS = 8
PEER_N_KEYS = 128
PEER_N_EXPERTS = PEER_N_KEYS * PEER_N_KEYS
PEER_KEY_DIM = 256
PEER_HALF = PEER_KEY_DIM // 2
PEER_TOPK = 16
PEER_TOK_BLOCK = 128

kernel_name = "hymba_nsa_ssd_peer_layer"


def rmsnorm(x, g):
    xf = x.astype(jnp.float32)
    y = xf * lax.rsqrt(jnp.mean(xf * xf, axis=-1, keepdims=True) + EPS)
    return (y * g.astype(jnp.float32)).astype(x.dtype)


def masked_softmax(s, mask):
    s = jnp.where(mask, s.astype(jnp.float32), -1e30)
    return jax.nn.softmax(s, axis=-1) * mask


def partial_rope(x, pos):
    half = ROPE_DIM // 2
    inv = jnp.power(ROPE_THETA, -jnp.arange(half, dtype=jnp.float32) * 2.0 / ROPE_DIM)
    ang = pos.astype(jnp.float32)[:, None] * inv[None, :]
    cos, sin = jnp.cos(ang).astype(x.dtype), jnp.sin(ang).astype(x.dtype)
    x1, x2, xp = x[..., :half], x[..., half:ROPE_DIM], x[..., ROPE_DIM:]
    return jnp.concatenate([x1 * cos - x2 * sin, x2 * cos + x1 * sin, xp], axis=-1)


def in_proj_splits():
    widths = [NSA_WIDTH] + [KV_WIDTH] * 6 + [3 * NSA_HEADS, SSD_WIDTH, SSD_CONV_DIM, SSD_HEADS]
    return [int(v) for v in np.cumsum(widths)[:-1]]


def compress(kv, pos_emb, w1, b1, w2):
    b, g, s, d = kv.shape
    chunks = kv.reshape(b, g, s // CMP_STRIDE, CMP_STRIDE, d)
    blocks = jnp.concatenate([chunks[:, :, :-1], chunks[:, :, 1:]], axis=3)
    blocks = (blocks + pos_emb).reshape(b, g, -1, CMP_BLOCK * d)
    return jax.nn.gelu(blocks @ w1 + b1) @ w2


def nsa_mixer(q, k_c, v_c, k_s, v_s, k_w, v_w, gates, cmp_k, cmp_v):
    b, g, r, s, d = q.shape
    scale = d ** -0.5
    t = jnp.arange(s)
    kc = compress(k_c, *cmp_k)
    vc = compress(v_c, *cmp_v)
    n_cmp = s // CMP_STRIDE - 1
    cmp_end = jnp.arange(n_cmp) * CMP_STRIDE + CMP_BLOCK - 1
    mask_c = cmp_end[None, :] <= t[:, None]
    p_cmp = masked_softmax(jnp.einsum('bgrtd,bgjd->bgrtj', q, kc) * scale, mask_c)
    o_cmp = jnp.einsum('bgrtj,bgjd->bgrtd', p_cmp.astype(vc.dtype), vc)
    n_sel = s // SEL_BLOCK
    n_top = min(SEL_TOP_N, n_sel)
    cs = np.arange(n_cmp) * CMP_STRIDE
    ss = np.arange(n_sel) * SEL_BLOCK
    overlap = (cs[:, None] < ss[None, :] + SEL_BLOCK) & (cs[:, None] + CMP_BLOCK > ss[None, :])
    overlap = jnp.asarray(overlap, jnp.float32)
    imp = jnp.einsum('bgrtj,ji->bgti', p_cmp, overlap)
    blk = jnp.arange(n_sel)
    cur = t // SEL_BLOCK
    forced = (blk[None, :] == 0) | (blk[None, :] == cur[:, None]) | (blk[None, :] == cur[:, None] - 1)
    valid = blk[None, :] <= cur[:, None]
    imp = jnp.where(forced, 1e9, jnp.where(valid, imp, -1.0))
    _, sel_idx = lax.top_k(imp, n_top)
    k_blk = k_s.reshape(b, g, n_sel, SEL_BLOCK, d)
    v_blk = v_s.reshape(b, g, n_sel, SEL_BLOCK, d)
    nqb = s // SEL_Q_BLOCK
    q_b = jnp.moveaxis(q.reshape(b, g, r, nqb, SEL_Q_BLOCK, d), 3, 0)
    idx_b = jnp.moveaxis(sel_idx.reshape(b, g, nqb, SEL_Q_BLOCK, n_top), 2, 0)
    t_b = t.reshape(nqb, SEL_Q_BLOCK)
    bi = jnp.arange(b)[:, None, None, None]
    gi = jnp.arange(g)[None, :, None, None]

    def sel_block(args):
        qb, ib, tb = args
        kg = k_blk[bi, gi, ib].reshape(b, g, SEL_Q_BLOCK, n_top * SEL_BLOCK, d)
        vg = v_blk[bi, gi, ib].reshape(b, g, SEL_Q_BLOCK, n_top * SEL_BLOCK, d)
        kpos = (ib[..., None] * SEL_BLOCK + jnp.arange(SEL_BLOCK)).reshape(b, g, SEL_Q_BLOCK, -1)
        mask = (kpos <= tb[:, None])[:, :, None]
        p = masked_softmax(jnp.einsum('bgrqd,bgqkd->bgrqk', qb, kg) * scale, mask)
        return jnp.einsum('bgrqk,bgqkd->bgrqd', p.astype(vg.dtype), vg)

    o_sel = lax.map(sel_block, (q_b, idx_b, t_b))
    o_sel = jnp.moveaxis(o_sel, 0, 3).reshape(b, g, r, s, d)
    nwb = s // WIN_Q_BLOCK
    n_ctx = WINDOW // WIN_Q_BLOCK + 1

    def band(kv):
        kp = jnp.pad(kv, ((0, 0), (0, 0), (WINDOW, 0), (0, 0))).reshape(b, g, nwb + n_ctx - 1, WIN_Q_BLOCK, d)
        return jnp.concatenate([kp[:, :, j:j + nwb] for j in range(n_ctx)], axis=3)

    kwb, vwb = band(k_w), band(v_w)
    qw = q.reshape(b, g, r, nwb, WIN_Q_BLOCK, d)
    tq = t.reshape(nwb, WIN_Q_BLOCK)
    tk = (jnp.arange(nwb)[:, None] - (n_ctx - 1)) * WIN_Q_BLOCK + jnp.arange(n_ctx * WIN_Q_BLOCK)[None, :]
    diff = tq[:, :, None] - tk[:, None, :]
    mask_w = (tk[:, None, :] >= 0) & (diff >= 0) & (diff < WINDOW)
    p_w = masked_softmax(jnp.einsum('bgrnqd,bgnkd->bgrnqk', qw, kwb) * scale, mask_w)
    o_win = jnp.einsum('bgrnqk,bgnkd->bgrnqd', p_w.astype(vwb.dtype), vwb).reshape(b, g, r, s, d)
    gr = gates.reshape(b, s, g, r, 3).transpose(0, 2, 3, 1, 4)
    o = gr[..., 0:1] * o_cmp + gr[..., 1:2] * o_sel + gr[..., 2:3] * o_win
    return o.transpose(0, 3, 1, 2, 4).reshape(b, s, g * r * d)


def ssd_mixer(z, xbc, dt, conv_w, conv_b, dt_bias, a_log, d_skip, norm_g):
    b, s, _ = xbc.shape
    xbc = lax.conv_general_dilated(xbc, conv_w[:, None, :], window_strides=(1,),
                                   padding=[(SSD_CONV - 1, 0)],
                                   dimension_numbers=('NWC', 'WIO', 'NWC'),
                                   feature_group_count=SSD_CONV_DIM) + conv_b
    xbc = jax.nn.silu(xbc)
    xs, bm, cm = jnp.split(xbc, [SSD_WIDTH, SSD_WIDTH + SSD_GROUPS * SSD_STATE], axis=-1)
    nc, l = s // SSD_CHUNK, SSD_CHUNK
    xs = xs.reshape(b, nc, l, SSD_GROUPS, SSD_REP, SSD_HEAD_DIM)
    bm = bm.reshape(b, nc, l, SSD_GROUPS, SSD_STATE).astype(jnp.float32)
    cm = cm.reshape(b, nc, l, SSD_GROUPS, SSD_STATE).astype(jnp.float32)
    dt = jax.nn.softplus(dt.astype(jnp.float32) + dt_bias.astype(jnp.float32))
    a = -jnp.exp(a_log.astype(jnp.float32))
    dt_c = dt.reshape(b, nc, l, SSD_GROUPS, SSD_REP)
    adt = (dt_c * a.reshape(SSD_GROUPS, SSD_REP)).transpose(0, 3, 4, 1, 2)
    xdt = xs.astype(jnp.float32) * dt_c[..., None]
    acum = jnp.cumsum(adt, axis=-1)
    causal = jnp.tril(jnp.ones((l, l), bool))
    seg = jnp.exp(jnp.where(causal, acum[..., :, None] - acum[..., None, :], -jnp.inf))
    cb = jnp.einsum('bclgn,bcsgn->bgcls', cm, bm)
    y_diag = jnp.einsum('bgcls,bgrcls,bcsgrp->bclgrp', cb, seg, xdt)
    decay_states = jnp.exp(acum[..., -1:] - acum)
    states = jnp.einsum('bclgn,bgrcl,bclgrp->cbgrpn', bm, decay_states, xdt)
    chunk_decay = jnp.moveaxis(jnp.exp(acum[..., -1]), -1, 0)

    def step(h, inp):
        st, dec = inp
        return h * dec[..., None, None] + st, h

    _, states_in = lax.scan(step, jnp.zeros(states.shape[1:], states.dtype), (states, chunk_decay))
    y_off = jnp.einsum('bclgn,cbgrpn,bgrcl->bclgrp', cm, states_in, jnp.exp(acum))
    y = y_diag + y_off + xs.astype(jnp.float32) * d_skip.astype(jnp.float32).reshape(SSD_GROUPS, SSD_REP, 1)
    y = y.reshape(b, s, SSD_WIDTH).astype(z.dtype)
    yg = (y * jax.nn.silu(z)).reshape(b, s, SSD_GROUPS, SSD_WIDTH // SSD_GROUPS)
    return rmsnorm(yg, norm_g.reshape(SSD_GROUPS, -1)).reshape(b, s, SSD_WIDTH)


def peer(x, w_q, sub_keys, w_u, w_v):
    b, s, dm = x.shape
    xt = x.reshape(b * s, dm)
    q = (xt @ w_q).reshape(-1, PEER_HEADS, 2, PEER_HALF)
    s1 = jnp.einsum('thd,hkd->thk', q[:, :, 0], sub_keys[:, 0])
    s2 = jnp.einsum('thd,hkd->thk', q[:, :, 1], sub_keys[:, 1])
    v1, i1 = lax.top_k(s1, PEER_TOPK)
    v2, i2 = lax.top_k(s2, PEER_TOPK)
    cand = (v1[..., :, None] + v2[..., None, :]).reshape(-1, PEER_HEADS, PEER_TOPK * PEER_TOPK)
    vals, ci = lax.top_k(cand, PEER_TOPK)
    e1 = jnp.take_along_axis(i1, ci // PEER_TOPK, axis=-1)
    e2 = jnp.take_along_axis(i2, ci % PEER_TOPK, axis=-1)
    idx = e1 * PEER_N_KEYS + e2
    gate = jax.nn.softmax(vals.astype(jnp.float32), axis=-1).astype(x.dtype)
    nb = xt.shape[0] // PEER_TOK_BLOCK

    def block(args):
        xb, ib, gb = args
        h = jax.nn.gelu(jnp.einsum('td,thkd->thk', xb, w_u[ib]))
        return jnp.einsum('thk,thkd->td', gb * h, w_v[ib])

    out = lax.map(block, (xt.reshape(nb, PEER_TOK_BLOCK, dm),
                          idx.reshape(nb, PEER_TOK_BLOCK, PEER_HEADS, PEER_TOPK),
                          gate.reshape(nb, PEER_TOK_BLOCK, PEER_HEADS, PEER_TOPK)))
    return out.reshape(b, s, dm)


def setup_inputs(seed: int = 0) -> dict:
    key = jax.random.key(seed)
    ks = jax.random.split(key, 32)
    n = jax.random.normal
    L = DEPTH
    dt0 = jnp.exp(jax.random.uniform(ks[14], (L, SSD_HEADS)) * (jnp.log(0.1) - jnp.log(0.001)) + jnp.log(0.001))
    return {
        "x": n(ks[0], (BATCH, SEQ, D_MODEL), jnp.float32),
        "attn_norm_g": 1.0 + 0.02 * n(ks[1], (L, D_MODEL)),
        "w_in": n(ks[2], (L, D_MODEL, IN_PROJ)) * D_MODEL ** -0.5,
        "cmp_pos_k": 0.02 * n(ks[3], (L, CMP_BLOCK, HEAD_DIM)),
        "cmp_w1_k": n(ks[4], (L, CMP_BLOCK * HEAD_DIM, CMP_HIDDEN)) * (CMP_BLOCK * HEAD_DIM) ** -0.5,
        "cmp_b1_k": 0.01 * n(ks[5], (L, CMP_HIDDEN)),
        "cmp_w2_k": n(ks[6], (L, CMP_HIDDEN, HEAD_DIM)) * CMP_HIDDEN ** -0.5,
        "cmp_pos_v": 0.02 * n(ks[7], (L, CMP_BLOCK, HEAD_DIM)),
        "cmp_w1_v": n(ks[8], (L, CMP_BLOCK * HEAD_DIM, CMP_HIDDEN)) * (CMP_BLOCK * HEAD_DIM) ** -0.5,
        "cmp_b1_v": 0.01 * n(ks[9], (L, CMP_HIDDEN)),
        "cmp_w2_v": n(ks[10], (L, CMP_HIDDEN, HEAD_DIM)) * CMP_HIDDEN ** -0.5,
        "conv_w": n(ks[11], (L, SSD_CONV, SSD_CONV_DIM)) * SSD_CONV ** -0.5,
        "conv_b": 0.01 * n(ks[12], (L, SSD_CONV_DIM)),
        "dt_bias": dt0 + jnp.log(-jnp.expm1(-dt0)),
        "a_log": jnp.log(jax.random.uniform(ks[13], (L, SSD_HEADS), minval=1.0, maxval=16.0)),
        "d_skip": 1.0 + 0.02 * n(ks[15], (L, SSD_HEADS)),
        "ssd_norm_g": 1.0 + 0.02 * n(ks[16], (L, SSD_WIDTH)),
        "nsa_norm_g": 1.0 + 0.02 * n(ks[17], (L, NSA_WIDTH)),
        "w_out": n(ks[18], (L, MIX_WIDTH, D_MODEL)) * MIX_WIDTH ** -0.5,
        "ffn_norm_g": 1.0 + 0.02 * n(ks[19], (L, D_MODEL)),
        "peer_w_q": n(ks[20], (L, D_MODEL, PEER_HEADS * PEER_KEY_DIM)) * D_MODEL ** -0.5,
        "peer_keys": n(ks[21], (L, PEER_HEADS, 2, PEER_N_KEYS, PEER_HALF)) * PEER_HALF ** -0.5,
        "peer_u": n(ks[22], (L, PEER_N_EXPERTS, D_MODEL)) * D_MODEL ** -0.5,
        "peer_v": n(ks[23], (L, PEER_N_EXPERTS, D_MODEL)) * PEER_HEADS ** -0.5,
        "final_norm_g": 1.0 + 0.02 * n(ks[24], (D_MODEL,)),
    }


def reference(x, attn_norm_g, w_in, cmp_pos_k, cmp_w1_k, cmp_b1_k, cmp_w2_k,
              cmp_pos_v, cmp_w1_v, cmp_b1_v, cmp_w2_v, conv_w, conv_b, dt_bias, a_log,
              d_skip, ssd_norm_g, nsa_norm_g, w_out, ffn_norm_g, peer_w_q, peer_keys,
              peer_u, peer_v, final_norm_g):
    b, s, _ = x.shape
    pos = jnp.arange(s)
    splits = in_proj_splits()
    for layer in range(DEPTH):
        h = rmsnorm(x, attn_norm_g[layer])
        proj = h @ w_in[layer]
        q, kc, vc, ksl, vsl, kw, vw, gl, z, xbc, dt = jnp.split(proj, splits, axis=-1)
        qh = partial_rope(q.reshape(b, s, NSA_KV_GROUPS, NSA_REP, HEAD_DIM).transpose(0, 2, 3, 1, 4), pos)

        def kv_heads(t_, rope):
            t_ = t_.reshape(b, s, NSA_KV_GROUPS, HEAD_DIM).transpose(0, 2, 1, 3)
            return partial_rope(t_, pos) if rope else t_

        gates = jax.nn.sigmoid(gl.astype(jnp.float32)).astype(x.dtype).reshape(b, s, NSA_HEADS, 3)
        o_nsa = nsa_mixer(qh, kv_heads(kc, True), kv_heads(vc, False), kv_heads(ksl, True),
                          kv_heads(vsl, False), kv_heads(kw, True), kv_heads(vw, False), gates,
                          (cmp_pos_k[layer], cmp_w1_k[layer], cmp_b1_k[layer], cmp_w2_k[layer]),
                          (cmp_pos_v[layer], cmp_w1_v[layer], cmp_b1_v[layer], cmp_w2_v[layer]))
        o_nsa = rmsnorm(o_nsa, nsa_norm_g[layer])
        o_ssd = ssd_mixer(z, xbc, dt, conv_w[layer], conv_b[layer], dt_bias[layer], a_log[layer],
                          d_skip[layer], ssd_norm_g[layer])
        x = x + jnp.concatenate([o_nsa, o_ssd.astype(o_nsa.dtype)], axis=-1) @ w_out[layer]
        x = x + peer(rmsnorm(x, ffn_norm_g[layer]), peer_w_q[layer], peer_keys[layer],
                     peer_u[layer], peer_v[layer])
    return rmsnorm(x, final_norm_g)
```

```cpp
#include <hip/hip_runtime.h>
#include <utility>
#include <hip/hip_cooperative_groups.h>
#include <cstdio>
#include <cstdint>
namespace cg = cooperative_groups;

#ifndef DO_ATTN
#define DO_ATTN 1
#endif
#ifndef DO_NSA
#define DO_NSA 1
#endif
#ifndef DO_SSD
#define DO_SSD 1
#endif
#ifndef DO_PEER
#define DO_PEER 1
#endif
#ifndef PROBE_PHASE
#define PROBE_PHASE -1
#endif
#ifndef PROBE_VARIANT
#define PROBE_VARIANT 0
#endif
#define KROT_MASK(nk_) ((nk_) - 1)
#ifndef N_LAUNCH_SPLIT
#define N_LAUNCH_SPLIT 0
#endif

#define DEVFI __device__ __forceinline__

typedef unsigned short bf16_t;
typedef short bf16x8 __attribute__((ext_vector_type(8)));
typedef float f32x16 __attribute__((ext_vector_type(16)));
typedef float f32x4 __attribute__((ext_vector_type(4)));
typedef float f32x2 __attribute__((ext_vector_type(2)));
typedef unsigned u32x4 __attribute__((ext_vector_type(4)));
typedef unsigned u32x2 __attribute__((ext_vector_type(2)));

constexpr int NTHR = 256;
constexpr int T = 65536, S = 4096, D = 1024;
constexpr int NPROJ_SRC = 2848, NPROJ = 2944;
constexpr float EPS = 1e-6f;
constexpr int LDS_BYTES = 80896;

constexpr size_t MiB = 1u << 20;
constexpr size_t WS_CTL = 0;
constexpr size_t WS_WIN = 1 * MiB;
constexpr size_t WS_WOUT = 7 * MiB;
constexpr size_t WS_WQ = 9 * MiB;
constexpr size_t WS_W1K = 13 * MiB;
constexpr size_t WS_W1V = 14 * MiB;
constexpr size_t WS_W2K = 15 * MiB;
constexpr size_t WS_W2V = 15 * MiB + 65536;
constexpr size_t WS_BIASK = 15 * MiB + 131072;
constexpr size_t WS_BIASV = 15 * MiB + 135168;
constexpr size_t WS_ROPE = 15 * MiB + 262144;
constexpr size_t WS_KEYS = 16 * MiB;
constexpr size_t WS_KCP = 17 * MiB;
constexpr size_t WS_SSN = 25 * MiB;
constexpr size_t WS_SSS = 27 * MiB;
constexpr size_t WS_SSX = 31 * MiB;
constexpr size_t WS_GATES = 35 * MiB;
constexpr size_t WS_DT = 41 * MiB;
constexpr size_t WS_U = 48 * MiB;
constexpr size_t WS_V = 64 * MiB;
constexpr size_t WS_SU = 80 * MiB;
constexpr size_t WS_SV = 80 * MiB + 65536;
constexpr size_t WS_XN = 112 * MiB;
constexpr size_t WS_Q = 240 * MiB;
constexpr size_t WS_KC = 304 * MiB;
constexpr size_t WS_VC = 320 * MiB;
constexpr size_t WS_KS = 336 * MiB;
constexpr size_t WS_VST = 352 * MiB;
constexpr size_t WS_KW = 368 * MiB;
constexpr size_t WS_VWT = 384 * MiB;
constexpr size_t WS_Z = 400 * MiB;
constexpr size_t WS_XBC = 464 * MiB;
constexpr size_t WS_AMAT = 592 * MiB;
constexpr size_t WS_X1B = 720 * MiB;
constexpr size_t WS_QP = 112 * MiB;
constexpr size_t WS_IDX = 400 * MiB;
constexpr size_t WS_GATE = 432 * MiB;
constexpr size_t WS_XBC2 = 848 * MiB;
constexpr size_t WS_X8 = WS_Q;
constexpr size_t WS_SX = WS_GATES;
constexpr size_t WS_SXN = WS_CTL + 512 * 1024;
constexpr size_t WS_SXR = WS_CTL + 256 * 1024;
constexpr size_t WS_SW = WS_CTL + 768 * 1024;
constexpr size_t WS_WQ8 = 20 * MiB;
constexpr size_t WS_SWQ = 22 * MiB;
constexpr size_t WS_X8T = WS_KC;
constexpr size_t WS_QF = WS_KW;
constexpr size_t WS_END = 976 * MiB;

struct Params {
    const float* in[25];
    float* out;
    unsigned char* ws;
    int ph_lo, ph_hi;
};

DEVFI unsigned pk_bf16(float lo, float hi) { unsigned r; asm("v_cvt_pk_bf16_f32 %0, %1, %2" : "=v"(r) : "v"(lo), "v"(hi)); return r; }
DEVFI float bf_lo(unsigned u) { return __uint_as_float(u << 16); }
DEVFI float bf_hi(unsigned u) { return __uint_as_float(u & 0xffff0000u); }
DEVFI float bf2f(bf16_t v) { return __uint_as_float(((unsigned)v) << 16); }
DEVFI bf16_t f2bf(float f) { return (bf16_t)(pk_bf16(f, 0.f) & 0xffffu); }
template <int CTRL> DEVFI float dpp_f(float v) { return __int_as_float(__builtin_amdgcn_update_dpp(0, __float_as_int(v), CTRL, 0xF, 0xF, true)); }
template <int CTRL> DEVFI unsigned dpp_u(unsigned v) { return (unsigned)__builtin_amdgcn_update_dpp(0, (int)v, CTRL, 0xF, 0xF, true); }
DEVFI float row16_sum(float v) { v += dpp_f<0x128>(v); v += dpp_f<0x124>(v); v += dpp_f<0x122>(v); v += dpp_f<0x121>(v); return v; }
DEVFI float row16_max(float v) { v = fmaxf(v, dpp_f<0x128>(v)); v = fmaxf(v, dpp_f<0x124>(v)); v = fmaxf(v, dpp_f<0x122>(v)); v = fmaxf(v, dpp_f<0x121>(v)); return v; }
DEVFI float xor1f(float v) { return dpp_f<0xB1>(v); }
DEVFI float xor2f(float v) { return dpp_f<0x4E>(v); }
DEVFI float xor4f(float v) { return dpp_f<0x141>(dpp_f<0x1B>(v)); }
DEVFI float xor32f(float x) {
#if __has_builtin(__builtin_amdgcn_permlane32_swap)
    const unsigned u = __float_as_uint(x);
    const auto pr = __builtin_amdgcn_permlane32_swap(u, u, false, false);
    return __uint_as_float((threadIdx.x & 32) ? pr[0] : pr[1]);
#else
    return __shfl_xor(x, 32);
#endif
}
DEVFI float xor16f(float x) {
#if __has_builtin(__builtin_amdgcn_permlane16_swap)
    const unsigned u = __float_as_uint(x);
    const auto pr = __builtin_amdgcn_permlane16_swap(u, u, false, false);
    return __uint_as_float((threadIdx.x & 16) ? pr[0] : pr[1]);
#else
    return __shfl_xor(x, 16);
#endif
}
DEVFI float wave_sum(float v) { v = row16_sum(v); v += xor16f(v); v += xor32f(v); return v; }
DEVFI float wave_max(float v) { v = row16_max(v); v = fmaxf(v, xor16f(v)); v = fmaxf(v, xor32f(v)); return v; }
DEVFI float gelu_tanh(float x) {
    const float u = 0.7978845608028654f * (x + 0.044715f * x * x * x);
    const float e = __expf(2.f * u);
    const float t = 1.f - 2.f * __builtin_amdgcn_rcpf(e + 1.f);
    return 0.5f * x * (1.f + t);
}
DEVFI float sigmoidf_(float x) { return __builtin_amdgcn_rcpf(1.f + __expf(-x)); }
DEVFI float siluf_(float x) { return x * __builtin_amdgcn_rcpf(1.f + __expf(-x)); }
DEVFI float softplusf_(float x) { return x > 20.f ? x : log1pf(__expf(x)); }
DEVFI unsigned xb_xcc_id();
DEVFI f32x16 mfma32(bf16x8 a, bf16x8 b, f32x16 c) { return __builtin_amdgcn_mfma_f32_32x32x16_bf16(a, b, c, 0, 0, 0); }
DEVFI f32x16 zero16() { f32x16 z;
#pragma unroll
    for (int i = 0; i < 16; ++i) z[i] = 0.f;
    return z; }
DEVFI int perm16(int o) { return (o & 3) | ((o & 4) << 1) | ((o & 8) >> 1); }

#define LAS3 __attribute__((address_space(3)))
template <int FT, int TT, int WNS, bool HOOK, class Epi>
DEVFI void gemm_tile(const bf16_t* __restrict__ A, size_t lda, const bf16_t* __restrict__ Bt, size_t ldb, int nk,
                     unsigned char* smem, Epi& epi, const int rot = 0) {
    int tid = threadIdx.x; asm volatile("" : "+v"(tid));
    const int lane = tid & 63, wid = __builtin_amdgcn_readfirstlane(tid >> 6);
    const int wm = (WNS == 2) ? (wid >> 1) : wid, wn = (WNS == 2) ? (wid & 1) : 0;
    constexpr int AROWS = (4 / WNS) * 32 * TT, BROWS = WNS * FT * 32;
    constexpr int ABYTES = AROWS * 128, BBYTES = BROWS * 128, BUFBYTES = ABYTES + BBYTES;
    LAS3 unsigned char* lds = (LAS3 unsigned char*)smem;
    const int grow = lane >> 3, gch = (lane & 7) ^ grow;
    const unsigned aoff = (unsigned)(((wid * 8 + grow) * (int)lda + gch * 8) * 2);
    const unsigned boff = (unsigned)(((wid * 8 + grow) * (int)ldb + gch * 8) * 2);
    f32x16 acc[FT][TT];
#pragma unroll
    for (int ft = 0; ft < FT; ++ft)
#pragma unroll
        for (int tt = 0; tt < TT; ++tt) acc[ft][tt] = zero16();
#define GEMM_ISSUE(kt_, buf_) do { \
        _Pragma("unroll") for (int i_ = 0; i_ < AROWS / 32; ++i_) \
            __builtin_amdgcn_global_load_lds((const unsigned*)((const char*)(A + (size_t)(i_ * 32) * lda + (((kt_) + rot) & KROT_MASK(nk)) * 64) + aoff), \
                                             (LAS3 unsigned*)(lds + (buf_) * BUFBYTES + (i_ * 4 + wid) * 1024), 16, 0, 0); \
        _Pragma("unroll") for (int i_ = 0; i_ < BROWS / 32; ++i_) \
            __builtin_amdgcn_global_load_lds((const unsigned*)((const char*)(Bt + (size_t)(i_ * 32) * ldb + (((kt_) + rot) & KROT_MASK(nk)) * 64) + boff), \
                                             (LAS3 unsigned*)(lds + (buf_) * BUFBYTES + ABYTES + (i_ * 4 + wid) * 1024), 16, 0, 0); \
    } while (0)
    GEMM_ISSUE(0, 0);
    asm volatile("s_waitcnt vmcnt(0)" ::: "memory");
    __syncthreads();
    const int frow = lane & 31, h5 = lane >> 5;
    for (int kt = 0; kt < nk; ++kt) {
        const int buf = kt & 1;
        if (kt + 1 < nk) GEMM_ISSUE(kt + 1, buf ^ 1);
        const unsigned char* as = smem + buf * BUFBYTES;
        const unsigned char* bs = as + ABYTES;
#pragma unroll
        for (int ks = 0; ks < 4; ++ks) {
            bf16x8 fa[FT], fb[TT];
#pragma unroll
            for (int ft = 0; ft < FT; ++ft) { const int rr = wn * FT * 32 + ft * 32 + frow; fa[ft] = *(const bf16x8*)(bs + rr * 128 + (((ks * 2 + h5) ^ (rr & 7)) << 4)); }
#pragma unroll
            for (int tt = 0; tt < TT; ++tt) { const int rr = wm * 32 * TT + tt * 32 + frow; fb[tt] = *(const bf16x8*)(as + rr * 128 + (((ks * 2 + h5) ^ (rr & 7)) << 4)); }
#pragma unroll
            for (int ft = 0; ft < FT; ++ft)
#pragma unroll
                for (int tt = 0; tt < TT; ++tt) acc[ft][tt] = mfma32(fa[ft], fb[tt], acc[ft][tt]);
        }
        if (HOOK) epi.hook(kt, acc);
        asm volatile("s_waitcnt vmcnt(0)" ::: "memory");
        __syncthreads();
    }
#undef GEMM_ISSUE
    epi(acc, wm, wn, lane);
}

template <int FT, int TT, bool HOOK, class Epi, int WNS = 2>
DEVFI void gemm_tile3(const bf16_t* __restrict__ A, size_t lda, const bf16_t* __restrict__ Bt, size_t ldb, int nk64,
                      unsigned char* smem, Epi& epi) {
    int tid = threadIdx.x; asm volatile("" : "+v"(tid));
    const int lane = tid & 63, wid = __builtin_amdgcn_readfirstlane(tid >> 6);
    const int wm = (WNS == 2) ? (wid >> 1) : wid, wn = (WNS == 2) ? (wid & 1) : 0;
    constexpr int AROWS = (4 / WNS) * 32 * TT, BROWS = WNS * FT * 32;
    constexpr int ABYTES = AROWS * 64, BBYTES = BROWS * 64, STBYTES = ABYTES + BBYTES;
    constexpr int NA = AROWS / 64, NB = BROWS / 64;
    static_assert(NA + NB == 6, "the counted wait below assumes 6 loads per wave per stage");
    static_assert(3 * STBYTES <= 73728, "ring must fit the LDS budget");
    LAS3 unsigned char* lds = (LAS3 unsigned char*)smem;
    const int nk = nk64 * 2;
    const int grow = lane >> 2, gch = (lane & 3) ^ ((grow >> 2) & 3);
    const unsigned aoff = (unsigned)(((wid * 16 + grow) * (int)lda + gch * 8) * 2);
    const unsigned boff = (unsigned)(((wid * 16 + grow) * (int)ldb + gch * 8) * 2);
    f32x16 acc[FT][TT];
#pragma unroll
    for (int ft = 0; ft < FT; ++ft)
#pragma unroll
        for (int tt = 0; tt < TT; ++tt) acc[ft][tt] = zero16();
#define GEMM3_ISSUE(kt_) do { const int st_ = (kt_) % 3; \
        _Pragma("unroll") for (int i_ = 0; i_ < NA; ++i_) \
            __builtin_amdgcn_global_load_lds((const unsigned*)((const char*)(A + (size_t)(i_ * 64) * lda + (kt_) * 32) + aoff), \
                                             (LAS3 unsigned*)(lds + st_ * STBYTES + (i_ * 4 + wid) * 1024), 16, 0, 0); \
        _Pragma("unroll") for (int i_ = 0; i_ < NB; ++i_) \
            __builtin_amdgcn_global_load_lds((const unsigned*)((const char*)(Bt + (size_t)(i_ * 64) * ldb + (kt_) * 32) + boff), \
                                             (LAS3 unsigned*)(lds + st_ * STBYTES + ABYTES + (i_ * 4 + wid) * 1024), 16, 0, 0); \
    } while (0)
    GEMM3_ISSUE(0);
    GEMM3_ISSUE(1);
    const int frow = lane & 31, h5 = lane >> 5;
    int st = 0;
    for (int kt = 0; kt < nk; ++kt) {
        if (kt + 1 < nk) asm volatile("s_waitcnt vmcnt(6)" ::: "memory"); else asm volatile("s_waitcnt vmcnt(0)" ::: "memory");
        asm volatile("s_waitcnt lgkmcnt(0)" ::: "memory");
        __builtin_amdgcn_s_barrier();
        asm volatile("" ::: "memory");
        if (kt + 2 < nk) GEMM3_ISSUE(kt + 2);
        const unsigned char* as = smem + st * STBYTES;
        const unsigned char* bs = as + ABYTES;
        st = (st == 2) ? 0 : st + 1;
#pragma unroll
        for (int ks = 0; ks < 2; ++ks) {
            bf16x8 fa[FT], fb[TT];
#pragma unroll
            for (int ft = 0; ft < FT; ++ft) { const int rr = wn * FT * 32 + ft * 32 + frow; fa[ft] = *(const bf16x8*)(bs + rr * 64 + (((ks * 2 + h5) ^ ((rr >> 2) & 3)) << 4)); }
#pragma unroll
            for (int tt = 0; tt < TT; ++tt) { const int rr = wm * 32 * TT + tt * 32 + frow; fb[tt] = *(const bf16x8*)(as + rr * 64 + (((ks * 2 + h5) ^ ((rr >> 2) & 3)) << 4)); }
#pragma unroll
            for (int ft = 0; ft < FT; ++ft)
#pragma unroll
                for (int tt = 0; tt < TT; ++tt) acc[ft][tt] = mfma32(fa[ft], fb[tt], acc[ft][tt]);
        }
        if (HOOK) { if (kt & 1) epi.hook(kt >> 1, acc); }
    }
#undef GEMM3_ISSUE
    asm volatile("s_waitcnt lgkmcnt(0)" ::: "memory");
    __builtin_amdgcn_s_barrier();
    asm volatile("" ::: "memory");
    epi(acc, wm, wn, lane);
}

typedef int i32x4v __attribute__((ext_vector_type(4)));
typedef int i32x16v __attribute__((ext_vector_type(16)));
template <int FT, int TT, class Epi>
DEVFI void gemm_tile3_i8(const unsigned char* __restrict__ A, size_t lda, const unsigned char* __restrict__ Bt, size_t ldb, int nk,
                         const float* __restrict__ rowscale, const float* __restrict__ colscale, unsigned char* smem, Epi& epi, const int rot = 0) {
    int tid = threadIdx.x; asm volatile("" : "+v"(tid));
    const int lane = tid & 63, wid = __builtin_amdgcn_readfirstlane(tid >> 6);
    const int wm = wid >> 1, wn = wid & 1;
    constexpr int AROWS = 2 * 32 * TT, BROWS = 2 * FT * 32;
    constexpr int ABYTES = AROWS * 64, BBYTES = BROWS * 64, STBYTES = ABYTES + BBYTES;
    constexpr int NA = AROWS / 64, NB = BROWS / 64;
    static_assert(NA + NB == 6, "the counted wait below assumes 6 loads per wave per stage");
    LAS3 unsigned char* lds = (LAS3 unsigned char*)smem;
    const int grow = lane >> 2, gch = (lane & 3) ^ ((grow >> 2) & 3);
    const unsigned aoff = (unsigned)((wid * 16 + grow) * (int)lda + gch * 16);
    const unsigned boff = (unsigned)((wid * 16 + grow) * (int)ldb + gch * 16);
    i32x16v acc[FT][TT];
#pragma unroll
    for (int ft = 0; ft < FT; ++ft)
#pragma unroll
        for (int tt = 0; tt < TT; ++tt)
#pragma unroll
            for (int i = 0; i < 16; ++i) acc[ft][tt][i] = 0;
#define GEMM3I_ISSUE(kt_) do { const int st_ = (kt_) % 3; \
        _Pragma("unroll") for (int i_ = 0; i_ < NA; ++i_) \
            __builtin_amdgcn_global_load_lds((const unsigned*)(A + (size_t)(i_ * 64) * lda + (((kt_) + rot) & KROT_MASK(nk)) * 64 + aoff), \
                                             (LAS3 unsigned*)(lds + st_ * STBYTES + (i_ * 4 + wid) * 1024), 16, 0, 0); \
        _Pragma("unroll") for (int i_ = 0; i_ < NB; ++i_) \
            __builtin_amdgcn_global_load_lds((const unsigned*)(Bt + (size_t)(i_ * 64) * ldb + (((kt_) + rot) & KROT_MASK(nk)) * 64 + boff), \
                                             (LAS3 unsigned*)(lds + st_ * STBYTES + ABYTES + (i_ * 4 + wid) * 1024), 16, 0, 0); \
    } while (0)
    GEMM3I_ISSUE(0);
    GEMM3I_ISSUE(1);
    const int frow = lane & 31, h5 = lane >> 5;
    int st = 0;
    for (int kt = 0; kt < nk; ++kt) {
        if (kt + 1 < nk) asm volatile("s_waitcnt vmcnt(6)" ::: "memory"); else asm volatile("s_waitcnt vmcnt(0)" ::: "memory");
        asm volatile("s_waitcnt lgkmcnt(0)" ::: "memory");
        __builtin_amdgcn_s_barrier();
        asm volatile("" ::: "memory");
        if (kt + 2 < nk) GEMM3I_ISSUE(kt + 2);
        const unsigned char* as = smem + st * STBYTES;
        const unsigned char* bs = as + ABYTES;
        st = (st == 2) ? 0 : st + 1;
#pragma unroll
        for (int ks = 0; ks < 2; ++ks) {
            i32x4v fa[FT], fb[TT];
#pragma unroll
            for (int ft = 0; ft < FT; ++ft) { const int rr = wn * FT * 32 + ft * 32 + frow; fa[ft] = *(const i32x4v*)(bs + rr * 64 + (((ks * 2 + h5) ^ ((rr >> 2) & 3)) << 4)); }
#pragma unroll
            for (int tt = 0; tt < TT; ++tt) { const int rr = wm * 32 * TT + tt * 32 + frow; fb[tt] = *(const i32x4v*)(as + rr * 64 + (((ks * 2 + h5) ^ ((rr >> 2) & 3)) << 4)); }
#pragma unroll
            for (int ft = 0; ft < FT; ++ft)
#pragma unroll
                for (int tt = 0; tt < TT; ++tt) acc[ft][tt] = __builtin_amdgcn_mfma_i32_32x32x32_i8(fa[ft], fb[tt], acc[ft][tt], 0, 0, 0);
        }
    }
#undef GEMM3I_ISSUE
    asm volatile("s_waitcnt lgkmcnt(0)" ::: "memory");
    __builtin_amdgcn_s_barrier();
    asm volatile("" ::: "memory");
    f32x16 accf[FT][TT];
#pragma unroll
    for (int tt = 0; tt < TT; ++tt) {
        const float rsc = rowscale[wm * 32 * TT + tt * 32 + frow];
#pragma unroll
        for (int ft = 0; ft < FT; ++ft)
#pragma unroll
            for (int gq = 0; gq < 4; ++gq) {
                const f32x4 cs = *(const f32x4*)(colscale + wn * FT * 32 + ft * 32 + 8 * gq + 4 * h5);
#pragma unroll
                for (int e = 0; e < 4; ++e) accf[ft][tt][4 * gq + e] = (float)acc[ft][tt][4 * gq + e] * (rsc * cs[e]);
            }
    }
    epi(accf, wm, wn, lane);
}

DEVFI int inproj_colmap(int n) {
    if (n < 1280) return n;
    if (n < 2816) return n + 24;
    if (n < 2840) return n - 1536;
    if (n < 2848) return n;
    return -1;
}
DEVFI void transpose_unit(const float* __restrict__ W, int K, int N, bf16_t* __restrict__ dst, int k0, int n0, bool inproj,
                          const float* __restrict__ g0, const float* __restrict__ g1, int gsplit, float* tile) {
    const int tid = threadIdx.x;
    const int n = tid & 63;
    int col = n0 + n;
    if (inproj) col = inproj_colmap(col);
#pragma unroll 4
    for (int i = 0; i < 16; ++i) {
        const int k = i * 4 + (tid >> 6);
        const int kk = k0 + k;
        float v = 0.f;
        if (col >= 0) {
            v = W[(size_t)kk * N + col];
            if (g0) v *= (kk < gsplit ? g0[kk] : g1[kk - gsplit]);
        }
        tile[k * 65 + n] = v;
    }
    __syncthreads();
    const int nn = tid >> 2, kq = tid & 3;
    unsigned o[8];
#pragma unroll
    for (int j = 0; j < 8; ++j) o[j] = pk_bf16(tile[(kq * 16 + 2 * j) * 65 + nn], tile[(kq * 16 + 2 * j + 1) * 65 + nn]);
    u32x4* d = (u32x4*)(dst + (size_t)(n0 + nn) * K + k0 + kq * 16);
    d[0] = (u32x4){o[0], o[1], o[2], o[3]};
    d[1] = (u32x4){o[4], o[5], o[6], o[7]};
    __syncthreads();
}

DEVFI void phase0(const Params& P_, unsigned char* smem) {
    size_t zoff_ = 0; asm volatile("" : "+s"(zoff_)); const Params& P = *(const Params*)((const char*)&P_ + zoff_);
    const int bid = blockIdx.x, nb = gridDim.x, tid = threadIdx.x, lane = tid & 63, w = tid >> 6;
    unsigned char* ws = P.ws;
    float* tile = (float*)smem;
    for (int u = bid; u < 46 * 8; u += nb) {
        const float* W = P.in[2]; const float* gn = P.in[1];
        const int cg = u >> 3, kb = u & 7, n0 = cg * 64;
        const int c4 = (tid & 15) * 4, rr = tid >> 4;
        const int col = inproj_colmap(n0 + c4);
        float* red = tile;
        float* qs = tile + 1024;
        unsigned char* t8 = (unsigned char*)(tile + 1088);
        f32x4 am4 = (f32x4){0.f, 0.f, 0.f, 0.f};
        if (col >= 0) {
#pragma unroll 1
            for (int k0 = 0; k0 < 1024; k0 += 128) {
                f32x4 v[8]; float g[8];
#pragma unroll
                for (int i = 0; i < 8; ++i) { v[i] = *(const f32x4*)(W + (size_t)(k0 + i * 16 + rr) * NPROJ_SRC + col); g[i] = fabsf(gn[k0 + i * 16 + rr]); }
#pragma unroll
                for (int i = 0; i < 8; ++i) {
                    am4.x = fmaxf(am4.x, fabsf(v[i].x) * g[i]); am4.y = fmaxf(am4.y, fabsf(v[i].y) * g[i]);
                    am4.z = fmaxf(am4.z, fabsf(v[i].z) * g[i]); am4.w = fmaxf(am4.w, fabsf(v[i].w) * g[i]);
                }
            }
        }
        *(f32x4*)(red + rr * 64 + c4) = am4;
        __syncthreads();
        if (tid < 64) {
            float a = 0.f;
#pragma unroll
            for (int r = 0; r < 16; ++r) a = fmaxf(a, red[r * 64 + tid]);
            qs[tid] = a > 0.f ? 127.f / a : 0.f;
            if (kb == 0) ((float*)(ws + WS_SW))[n0 + tid] = a * (1.f / 127.f);
        }
        __syncthreads();
        {
            const f32x4 q4 = *(const f32x4*)(qs + c4);
#pragma unroll
            for (int i = 0; i < 8; ++i) {
                const int kl = i * 16 + rr, k = kb * 128 + kl;
                f32x4 v = (f32x4){0.f, 0.f, 0.f, 0.f};
                if (col >= 0) v = *(const f32x4*)(W + (size_t)k * NPROJ_SRC + col);
                const float g = gn[k];
                t8[(c4 + 0) * 144 + kl] = (unsigned char)(int)rintf(v.x * g * q4.x);
                t8[(c4 + 1) * 144 + kl] = (unsigned char)(int)rintf(v.y * g * q4.y);
                t8[(c4 + 2) * 144 + kl] = (unsigned char)(int)rintf(v.z * g * q4.z);
                t8[(c4 + 3) * 144 + kl] = (unsigned char)(int)rintf(v.w * g * q4.w);
            }
        }
        __syncthreads();
        {
            const int nn = tid >> 2, kq = tid & 3;
            const u32x4 o0 = *(const u32x4*)(t8 + nn * 144 + kq * 32), o1 = *(const u32x4*)(t8 + nn * 144 + kq * 32 + 16);
            u32x4* d = (u32x4*)(ws + WS_WIN + (size_t)(n0 + nn) * 1024 + kb * 128 + kq * 32);
            d[0] = o0; d[1] = o1;
        }
        __syncthreads();
    }
    for (int u = bid; u < 16 * 16; u += nb)
        transpose_unit(P.in[18], 1024, 1024, (bf16_t*)(ws + WS_WOUT), (u / 16) * 64, (u % 16) * 64, false, P.in[17], P.in[16], 512, tile);
    for (int u = bid; u < 512; u += nb) {
        const int h2 = u >> 5;
        float* ks = tile;
        float* wq = tile + 128 * 129;
        const float* keys = P.in[21] + (size_t)h2 * 16384;
        for (int i = tid; i < 4096; i += NTHR) {
            const f32x4 a = *(const f32x4*)(keys + i * 4);
            float* d = ks + (i >> 5) * 129 + (i & 31) * 4;
            d[0] = a.x; d[1] = a.y; d[2] = a.z; d[3] = a.w;
        }
#pragma unroll 1
        for (int m = 0; m < 2; ++m) {
            const int k0 = ((u & 31) * 2 + m) * 16;
            for (int i = tid; i < 512; i += NTHR)
                *(f32x4*)(wq + (i >> 5) * 128 + (i & 31) * 4) = *(const f32x4*)(P.in[20] + (size_t)(k0 + (i >> 5)) * 2048 + h2 * 128 + (i & 31) * 4);
            __syncthreads();
            const int key = tid & 127, kh = tid >> 7;
            float aw[8];
#pragma unroll
            for (int j = 0; j < 8; ++j) aw[j] = 0.f;
#pragma unroll 2
            for (int d = 0; d < 128; d += 4) {
                const float a0 = ks[key * 129 + d], a1 = ks[key * 129 + d + 1], a2 = ks[key * 129 + d + 2], a3 = ks[key * 129 + d + 3];
#pragma unroll
                for (int j = 0; j < 8; ++j) {
                    const f32x4 wv = *(const f32x4*)(wq + (kh * 8 + j) * 128 + d);
                    aw[j] += (a0 * wv.x + a1 * wv.y) + (a2 * wv.z + a3 * wv.w);
                }
            }
            const float* g = P.in[19] + k0 + kh * 8;
            *(u32x4*)((bf16_t*)(ws + WS_WQ) + (size_t)(h2 * 128 + key) * 1024 + k0 + kh * 8) =
                (u32x4){pk_bf16(aw[0] * g[0], aw[1] * g[1]), pk_bf16(aw[2] * g[2], aw[3] * g[3]), pk_bf16(aw[4] * g[4], aw[5] * g[5]), pk_bf16(aw[6] * g[6], aw[7] * g[7])};
            __syncthreads();
        }
    }
#define ROT_BID(off_) ((bid + nb - ((off_) % nb)) % nb)
    for (int u = ROT_BID(256); u < 32 * 4; u += nb)
        transpose_unit(P.in[4], 2048, 256, (bf16_t*)(ws + WS_W1K), (u / 4) * 64, (u % 4) * 64, false, nullptr, nullptr, 0, tile);
    for (int u = ROT_BID(384); u < 32 * 4; u += nb)
        transpose_unit(P.in[8], 2048, 256, (bf16_t*)(ws + WS_W1V), (u / 4) * 64, (u % 4) * 64, false, nullptr, nullptr, 0, tile);
    for (int u = ROT_BID(368); u < 4; u += nb)
        transpose_unit(P.in[6], 256, 64, (bf16_t*)(ws + WS_W2K), u * 64, 0, false, nullptr, nullptr, 0, tile);
    for (int u = ROT_BID(372); u < 4; u += nb)
        transpose_unit(P.in[10], 256, 64, (bf16_t*)(ws + WS_W2V), u * 64, 0, false, nullptr, nullptr, 0, tile);
    {
        const float* x = P.in[0];
        unsigned char* xn8 = ws + WS_XN;
        float* sxn = (float*)(ws + WS_SXN);
        for (int row0 = (bid * 4 + w) * 4; row0 < T; row0 += nb * 16) {
            f32x4 v[4][4];
#pragma unroll
            for (int rr = 0; rr < 4; ++rr) {
                const f32x4* xr = (const f32x4*)(x + (size_t)(row0 + rr) * D) + lane;
#pragma unroll
                for (int j = 0; j < 4; ++j) v[rr][j] = xr[64 * j];
            }
#pragma unroll
            for (int rr = 0; rr < 4; ++rr) {
                float ss = 0.f, am = 0.f;
#pragma unroll
                for (int j = 0; j < 4; ++j) {
                    ss += v[rr][j].x * v[rr][j].x + v[rr][j].y * v[rr][j].y + v[rr][j].z * v[rr][j].z + v[rr][j].w * v[rr][j].w;
                    am = fmaxf(am, fmaxf(fmaxf(fabsf(v[rr][j].x), fabsf(v[rr][j].y)), fmaxf(fabsf(v[rr][j].z), fabsf(v[rr][j].w))));
                }
                ss = wave_sum(ss);
                am = wave_max(am);
                const float rs = rsqrtf(ss * (1.f / D) + EPS);
                const float qs = am > 0.f ? 127.f / am : 0.f;
                unsigned* o = (unsigned*)(xn8 + (size_t)(row0 + rr) * D) + lane;
#pragma unroll
                for (int j = 0; j < 4; ++j) {
                    const int q0 = (int)rintf(v[rr][j].x * qs), q1 = (int)rintf(v[rr][j].y * qs), q2 = (int)rintf(v[rr][j].z * qs), q3 = (int)rintf(v[rr][j].w * qs);
                    o[64 * j] = ((unsigned)q0 & 255u) | (((unsigned)q1 & 255u) << 8) | (((unsigned)q2 & 255u) << 16) | (((unsigned)q3 & 255u) << 24);
                }
                if (lane == 0) { sxn[row0 + rr] = am * rs * (1.f / 127.f); ((float*)(ws + WS_SXR))[row0 + rr] = am * (1.f / 127.f); }
            }
        }
    }
    {
        const float* g = P.in[19];
        unsigned char* U8 = ws + WS_U;
        unsigned char* V8 = ws + WS_V;
        float* SU = (float*)(ws + WS_SU);
        float* SV = (float*)(ws + WS_SV);
        f32x4 gg[4];
#pragma unroll
        for (int q = 0; q < 4; ++q) gg[q] = *(const f32x4*)(g + lane * 16 + 4 * q);
        for (int row0 = (bid * 4 + w) * 4; row0 < 32768; row0 += nb * 16) {
            const bool isv = row0 >= 16384;
            const int e0 = row0 & 16383;
            const float* src = (isv ? P.in[23] : P.in[22]) + (size_t)e0 * 1024 + lane * 16;
            f32x4 v[4][4];
#pragma unroll
            for (int rr = 0; rr < 4; ++rr)
#pragma unroll
                for (int q = 0; q < 4; ++q) v[rr][q] = *(const f32x4*)(src + (size_t)rr * 1024 + 4 * q);
#pragma unroll
            for (int rr = 0; rr < 4; ++rr) {
                const int e = e0 + rr;
                if (!isv) {
#pragma unroll
                    for (int q = 0; q < 4; ++q) { v[rr][q].x *= gg[q].x; v[rr][q].y *= gg[q].y; v[rr][q].z *= gg[q].z; v[rr][q].w *= gg[q].w; }
                }
                float am = 0.f, sq = 0.f;
#pragma unroll
                for (int q = 0; q < 4; ++q) {
                    am = fmaxf(am, fmaxf(fmaxf(fabsf(v[rr][q].x), fabsf(v[rr][q].y)), fmaxf(fabsf(v[rr][q].z), fabsf(v[rr][q].w))));
                    sq += (v[rr][q].x * v[rr][q].x + v[rr][q].y * v[rr][q].y) + (v[rr][q].z * v[rr][q].z + v[rr][q].w * v[rr][q].w);
                }
                am = wave_max(am);
                const float qmax = isv ? 6.f : 7.f;
                if (!isv) {
                    const float rms = sqrtf(wave_sum(sq) * (1.f / 1024.f));
                    am = fminf(am, 7.f * 0.36f * rms);
                }
                const float sc = am > 0.f ? qmax / am : 1.f;
                unsigned pk[4];
#pragma unroll
                for (int q = 0; q < 4; ++q) {
                    if (isv) {
                        if ((q & 1) == 0) {
                            pk[q >> 1] = __builtin_amdgcn_cvt_scalef32_pk_fp4_f32(0u, v[rr][q].x * sc, v[rr][q].y * sc, 1.0f, 0);
                            pk[q >> 1] = __builtin_amdgcn_cvt_scalef32_pk_fp4_f32(pk[q >> 1], v[rr][q].z * sc, v[rr][q].w * sc, 1.0f, 1);
                        } else {
                            pk[q >> 1] = __builtin_amdgcn_cvt_scalef32_pk_fp4_f32(pk[q >> 1], v[rr][q].x * sc, v[rr][q].y * sc, 1.0f, 2);
                            pk[q >> 1] = __builtin_amdgcn_cvt_scalef32_pk_fp4_f32(pk[q >> 1], v[rr][q].z * sc, v[rr][q].w * sc, 1.0f, 3);
                        }
                    } else {
                        const int q0 = (int)fminf(fmaxf(rintf(v[rr][q].x * sc), -7.f), 7.f), q1 = (int)fminf(fmaxf(rintf(v[rr][q].y * sc), -7.f), 7.f);
                        const int q2 = (int)fminf(fmaxf(rintf(v[rr][q].z * sc), -7.f), 7.f), q3 = (int)fminf(fmaxf(rintf(v[rr][q].w * sc), -7.f), 7.f);
                        const unsigned h16 = ((unsigned)q0 & 15u) | (((unsigned)q1 & 15u) << 4) | (((unsigned)q2 & 15u) << 8) | (((unsigned)q3 & 15u) << 12);
                        if ((q & 1) == 0) pk[q >> 1] = h16; else pk[q >> 1] |= h16 << 16;
                    }
                }
                *(u32x2*)((isv ? V8 : U8) + (size_t)(lane >> 4) * (16384 * 128) + (size_t)e * 128 + (lane & 15) * 8) = (u32x2){pk[0], pk[1]};
                if (lane == 0) (isv ? SV : SU)[e] = am > 0.f ? am / qmax : 1.f;
            }
        }
    }
    for (int u = ROT_BID(376); u < 8; u += nb) {
        const int kv = u >> 2, n = (u & 3) * 64 + (tid & 63), kq = tid >> 6;
        const float* pos = P.in[kv ? 7 : 3];
        const float* w1 = P.in[kv ? 8 : 4];
        const float* b1 = P.in[kv ? 9 : 5];
        float* bo = (float*)(ws + (kv ? WS_BIASV : WS_BIASK));
        float a0 = 0.f, a1 = 0.f, a2 = 0.f, a3 = 0.f;
#pragma unroll 4
        for (int k = kq * 512; k < kq * 512 + 512; k += 4) {
            a0 += pos[k] * w1[(size_t)k * 256 + n];
            a1 += pos[k + 1] * w1[(size_t)(k + 1) * 256 + n];
            a2 += pos[k + 2] * w1[(size_t)(k + 2) * 256 + n];
            a3 += pos[k + 3] * w1[(size_t)(k + 3) * 256 + n];
        }
        tile[tid] = (a0 + a1) + (a2 + a3);
        __syncthreads();
        if (tid < 64) bo[n] = b1[n] + (tile[tid] + tile[tid + 64]) + (tile[tid + 128] + tile[tid + 192]);
        __syncthreads();
    }
    {
        float* rt = (float*)(ws + WS_ROPE);
        for (int i = bid * NTHR + tid; i < 4096 * 8; i += nb * NTHR) {
            const int s = i >> 3, f = i & 7;
            const float inv = powf(500000.0f, -(float)f * 2.0f / 16.0f);
            const float ang = (float)s * inv;
            rt[s * 16 + f] = cosf(ang);
            rt[s * 16 + 8 + f] = sinf(ang);
        }
    }
}

struct EpiInProj {
    int m0, nt;
    unsigned char* ws;
    const float* dt_bias;
    unsigned char* stage;
    template <int TT> DEVFI void hook(int, f32x16 (&)[2][TT]) const {}
    template <int TT> DEVFI void operator()(f32x16 (&acc)[2][TT], int wm, int wn, int lane) const {
        const int h5 = lane >> 5, r = lane & 31;
        bf16_t* st = (bf16_t*)(stage + (wm * 2 + wn) * 6144);
        const int tok0 = m0 + wm * 32 * TT;
        const int b = tok0 >> 12;
        if (nt == 22) {
            if (wn == 0) {
#pragma unroll
                for (int tt = 0; tt < TT; ++tt) {
                    const int tok = tok0 + tt * 32 + r;
                    float* gp = (float*)(ws + WS_GATES) + (size_t)tok * 24;
#pragma unroll
                    for (int gq = 0; gq < 3; ++gq) {
                        f32x4 v;
#pragma unroll
                        for (int e = 0; e < 4; ++e) v[e] = sigmoidf_(acc[0][tt][4 * gq + e]);
                        *(f32x4*)(gp + 8 * gq + 4 * h5) = v;
                    }
                    f32x4 v;
#pragma unroll
                    for (int e = 0; e < 4; ++e) v[e] = softplusf_(acc[0][tt][12 + e] + dt_bias[4 * h5 + e]);
                    *(f32x4*)((float*)(ws + WS_DT) + (size_t)tok * 8 + 4 * h5) = v;
                }
            }
            return;
        }
        const bool is_q = nt < 4;
        const bool rope = is_q || nt == 4 || nt == 6 || nt == 8;
        const bool transposed = (nt == 7 || nt == 9);
        const float sc = is_q ? 0.125f * 1.4426950408889634f : 1.f;
        bf16_t* dst; int rstride;
        if (is_q) { dst = (bf16_t*)(ws + WS_Q) + ((size_t)(b * 8 + nt * 2 + wn) * 4096 + (tok0 & 4095)) * 64; rstride = 64; }
        else if (nt < 10) {
            const size_t off = (nt == 4) ? WS_KC : (nt == 5) ? WS_VC : (nt == 6) ? WS_KS : (nt == 7) ? WS_VST : (nt == 8) ? WS_KW : WS_VWT;
            if (transposed) { dst = (bf16_t*)(ws + off) + (size_t)(b * 2 + wn) * 64 * 4096 + (tok0 & 4095); rstride = 4096; }
            else { dst = (bf16_t*)(ws + off) + ((size_t)(b * 2 + wn) * 4096 + (tok0 & 4095)) * 64; rstride = 64; }
        }
        else if (nt < 14) { dst = (bf16_t*)(ws + WS_Z) + (size_t)tok0 * 512 + (nt - 10) * 128 + wn * 64; rstride = 512; }
        else { dst = (bf16_t*)(ws + WS_XBC) + (size_t)tok0 * 1024 + (nt - 14) * 128 + wn * 64; rstride = 1024; }
#pragma unroll
        for (int tt = 0; tt < TT; ++tt) {
            if (rope) {
                const int s = (tok0 + tt * 32 + r) & 4095;
                const float* rt = (const float*)(ws + WS_ROPE) + s * 16 + 4 * h5;
                const f32x4 c = *(const f32x4*)rt, sn = *(const f32x4*)(rt + 8);
#pragma unroll
                for (int e = 0; e < 4; ++e) {
                    const float x1 = acc[0][tt][e], x2 = acc[0][tt][4 + e];
                    acc[0][tt][e] = x1 * c[e] - x2 * sn[e];
                    acc[0][tt][4 + e] = x2 * c[e] + x1 * sn[e];
                }
            }
            if (!transposed) {
#pragma unroll
                for (int ft = 0; ft < 2; ++ft)
#pragma unroll
                    for (int gq = 0; gq < 4; ++gq)
                        *(u32x2*)(st + r * 72 + ft * 32 + 8 * gq + 4 * h5) = (u32x2){pk_bf16(acc[ft][tt][4 * gq] * sc, acc[ft][tt][4 * gq + 1] * sc),
                                                                                   pk_bf16(acc[ft][tt][4 * gq + 2] * sc, acc[ft][tt][4 * gq + 3] * sc)};
#pragma unroll
                for (int i = 0; i < 4; ++i) {
                    const int row = i * 8 + (lane >> 3), c8 = (lane & 7) * 8;
                    *(u32x4*)(dst + (size_t)(tt * 32 + row) * rstride + c8) = *(const u32x4*)(st + row * 72 + c8);
                }
            } else {
                const int pr = (r & ~15) + perm16(r & 15);
#pragma unroll
                for (int ft = 0; ft < 2; ++ft)
#pragma unroll
                    for (int i = 0; i < 16; ++i) {
                        const int d = ft * 32 + 8 * (i >> 2) + 4 * h5 + (i & 3);
                        st[d * 40 + pr] = f2bf(acc[ft][tt][i]);
                    }
#pragma unroll
                for (int i = 0; i < 4; ++i) {
                    const int drow = i * 16 + (lane >> 2), c8 = (lane & 3) * 8;
                    *(u32x4*)(dst + (size_t)drow * 4096 + tt * 32 + c8) = *(const u32x4*)(st + drow * 40 + c8);
                }
            }
        }
    }
};

template <int TT> struct EpiCompress {
    const float* bias;
    bf16_t* Hs;
    DEVFI void hook(int, f32x16 (&)[2][TT]) const {}
    DEVFI void operator()(f32x16 (&acc)[2][TT], int wm, int wn, int lane) const {
        const int h5 = lane >> 5, r = lane & 31;
#pragma unroll
        for (int tt = 0; tt < TT; ++tt) {
            const int row = wm * 32 * TT + tt * 32 + r;
#pragma unroll
            for (int ft = 0; ft < 2; ++ft)
#pragma unroll
                for (int gq = 0; gq < 4; ++gq) {
                    const int f0 = wn * 64 + ft * 32 + 8 * gq + 4 * h5;
                    const f32x4 bv = *(const f32x4*)(bias + f0);
                    float v[4];
#pragma unroll
                    for (int e = 0; e < 4; ++e) v[e] = gelu_tanh(acc[ft][tt][4 * gq + e] + bv[e]);
                    *(u32x2*)(Hs + row * 136 + f0) = (u32x2){pk_bf16(v[0], v[1]), pk_bf16(v[2], v[3])};
                }
        }
    }
};
DEVFI void compress_item(const Params& P_, int item, unsigned char* smem) {
    const int kv = item >> 7, rt = item & 127;
    size_t zoff_ = 0; asm volatile("" : "+s"(zoff_)); const Params& P = *(const Params*)((const char*)&P_ + zoff_); unsigned char* ws = P.ws + zoff_;
    const int tid = threadIdx.x, lane = tid & 63, w = tid >> 6;
    const bf16_t* A = (const bf16_t*)(ws + (kv ? WS_VC : WS_KC)) + (size_t)rt * 64 * 1024;
    const bf16_t* W2t = (const bf16_t*)(ws + (kv ? WS_W2V : WS_W2K));
    const int r = lane & 31, h5 = lane >> 5;
    const int rtile = w & 1, ft = w >> 1;
    f32x16 o = zero16();
#pragma unroll 1
    for (int nh = 0; nh < 2; ++nh) {
        const bf16_t* Bt = (const bf16_t*)(ws + (kv ? WS_W1V : WS_W1K)) + (size_t)nh * 128 * 2048;
        EpiCompress<1> epi;
        epi.bias = (const float*)(ws + (kv ? WS_BIASV : WS_BIASK)) + nh * 128;
        epi.Hs = (bf16_t*)smem;
        gemm_tile<2, 1, 2, false>(A, 1024, Bt, 2048, 32, smem, epi);
        __syncthreads();
#pragma unroll
        for (int ks = 0; ks < 8; ++ks) {
            const bf16x8 fb = *(const bf16x8*)(epi.Hs + (32 * rtile + r) * 136 + ks * 16 + 8 * h5);
            const bf16x8 fa = *(const bf16x8*)(W2t + (size_t)(ft * 32 + r) * 256 + nh * 128 + ks * 16 + 8 * h5);
            o = mfma32(fa, fb, o);
        }
        __syncthreads();
    }
    const int R = rt * 64 + 32 * rtile + r;
    const bool dead = (R & 255) == 255;
    if (dead) o = zero16();
    if (kv == 0) {
        bf16_t* dst = (bf16_t*)(ws + WS_KCP) + (size_t)R * 64 + ft * 32 + 4 * h5;
#pragma unroll
        for (int gq = 0; gq < 4; ++gq) *(u32x2*)(dst + 8 * gq) = (u32x2){pk_bf16(o[4 * gq], o[4 * gq + 1]), pk_bf16(o[4 * gq + 2], o[4 * gq + 3])};
    } else {
        const int bgi = R >> 8, j = R & 255, jp = (j & ~15) + perm16(j & 15);
        bf16_t* dst = (bf16_t*)(ws + WS_KCP + MiB) + ((size_t)bgi * 64 + ft * 32 + 4 * h5) * 256 + jp;
#pragma unroll
        for (int i = 0; i < 16; ++i) dst[(size_t)(8 * (i >> 2) + (i & 3)) * 256] = f2bf(o[i]);
    }
}

constexpr int KS72 = 72;
DEVFI void nsa_qk(const bf16_t* kb, int kt2, const bf16x8 (&qf)[2][4], f32x16 (&st)[2], int r, int h5) {
    st[0] = zero16(); st[1] = zero16();
#pragma unroll
    for (int ks = 0; ks < 4; ++ks) {
        const bf16x8 fa = *(const bf16x8*)(kb + (kt2 * 32 + r) * KS72 + ks * 16 + 8 * h5);
#pragma unroll
        for (int tt = 0; tt < 2; ++tt) st[tt] = mfma32(fa, qf[tt][ks], st[tt]);
    }
}
DEVFI void nsa_pv(const bf16_t* vb, int kt2, const f32x16 (&st)[2], f32x16 (&O)[2][2], int r, int h5) {
#pragma unroll
    for (int s2 = 0; s2 < 2; ++s2) {
        bf16x8 pf[2];
#pragma unroll
        for (int tt = 0; tt < 2; ++tt) {
            union { bf16x8 v; unsigned u[4]; } cv;
#pragma unroll
            for (int j = 0; j < 4; ++j) cv.u[j] = pk_bf16(st[tt][8 * s2 + 2 * j], st[tt][8 * s2 + 2 * j + 1]);
            pf[tt] = cv.v;
        }
#pragma unroll
        for (int dt = 0; dt < 2; ++dt) {
            const bf16x8 fa = *(const bf16x8*)(vb + (dt * 32 + r) * KS72 + kt2 * 32 + s2 * 16 + 8 * h5);
#pragma unroll
            for (int tt = 0; tt < 2; ++tt) O[dt][tt] = mfma32(fa, pf[tt], O[dt][tt]);
        }
    }
}
template <bool WITH_O>
DEVFI void nsa_softmax(f32x16 (&st)[2], int kt2, int lo, int hi, float (&mrun)[2], float (&lrun)[2], f32x16 (&O)[2][2], int h5) {
    float mx[2] = {-1e30f, -1e30f};
#pragma unroll
    for (int i = 0; i < 16; ++i) {
        const int keyl = kt2 * 32 + 8 * (i >> 2) + 4 * h5 + (i & 3);
        const bool ok = (keyl > lo) && (keyl <= hi);
#pragma unroll
        for (int tt = 0; tt < 2; ++tt) { const float sv = ok ? st[tt][i] : -1e30f; st[tt][i] = sv; mx[tt] = fmaxf(mx[tt], sv); }
    }
    float alpha[2];
#pragma unroll
    for (int tt = 0; tt < 2; ++tt) {
        mx[tt] = fmaxf(mx[tt], xor32f(mx[tt]));
        const float mn = fmaxf(mrun[tt], mx[tt]);
        alpha[tt] = __builtin_amdgcn_exp2f(mrun[tt] - mn);
        mrun[tt] = mn;
        float rs_ = 0.f;
#pragma unroll
        for (int i = 0; i < 16; ++i) {
            const float sv = st[tt][i];
            const float p = (sv > -1e29f) ? __builtin_amdgcn_exp2f(sv - mn) : 0.f;
            st[tt][i] = p; rs_ += p;
        }
        rs_ += xor32f(rs_);
        lrun[tt] = lrun[tt] * alpha[tt] + rs_;
    }
    if (WITH_O) {
        if (__any(alpha[0] != 1.f || alpha[1] != 1.f)) {
#pragma unroll
            for (int tt = 0; tt < 2; ++tt)
#pragma unroll
                for (int dt = 0; dt < 2; ++dt)
#pragma unroll
                    for (int i = 0; i < 16; ++i) O[dt][tt][i] *= alpha[tt];
        }
    }
}

DEVFI void nsa_softmax_fast(f32x16 (&st)[2], bool lane_ok, float (&mrun)[2], float (&lrun)[2], f32x16 (&O)[2][2]) {
    float alpha[2];
#pragma unroll
    for (int tt = 0; tt < 2; ++tt) {
        float mx = fmaxf(fmaxf(st[tt][0], st[tt][1]), fmaxf(st[tt][2], st[tt][3]));
#pragma unroll
        for (int i = 4; i < 16; i += 4) mx = fmaxf(mx, fmaxf(fmaxf(st[tt][i], st[tt][i + 1]), fmaxf(st[tt][i + 2], st[tt][i + 3])));
        mx = fmaxf(mx, xor32f(mx));
        mx = lane_ok ? mx : -1e30f;
        const float mn = fmaxf(mrun[tt], mx);
        alpha[tt] = __builtin_amdgcn_exp2f(mrun[tt] - mn);
        mrun[tt] = mn;
        const float msub = lane_ok ? mn : 1e30f;
        float rs0 = 0.f, rs1 = 0.f;
#pragma unroll
        for (int i = 0; i < 16; i += 2) {
            const float p0 = __builtin_amdgcn_exp2f(st[tt][i] - msub), p1 = __builtin_amdgcn_exp2f(st[tt][i + 1] - msub);
            st[tt][i] = p0; st[tt][i + 1] = p1; rs0 += p0; rs1 += p1;
        }
        float rs_ = rs0 + rs1;
        rs_ += xor32f(rs_);
        lrun[tt] = lrun[tt] * alpha[tt] + rs_;
    }
    if (__any(alpha[0] != 1.f || alpha[1] != 1.f)) {
#pragma unroll
        for (int tt = 0; tt < 2; ++tt)
#pragma unroll
            for (int dt = 0; dt < 2; ++dt)
#pragma unroll
                for (int i = 0; i < 16; ++i) O[dt][tt][i] *= alpha[tt];
    }
}

DEVFI void nsa_item(const Params& P_, int bg, int qb, unsigned char* smem, const int variant) {
    size_t zoff_ = 0; asm volatile("" : "+s"(zoff_)); const Params& P = *(const Params*)((const char*)&P_ + zoff_); unsigned char* ws = P.ws + zoff_;
    int tid = threadIdx.x; asm volatile("" : "+v"(tid));
    const int lane = tid & 63, w = tid >> 6;
    const int b = bg >> 1, g = bg & 1;
    bf16_t* sK = (bf16_t*)smem;
    bf16_t* sV = sK + 2 * 64 * KS72;
    float* sA = (float*)(sV + 2 * 64 * KS72);
    float* sL = sA + 64 * 65;
    unsigned* sM = (unsigned*)(sL + 64 * 65);
    bf16_t* sO = (bf16_t*)sA;
    const int r = lane & 31, h5 = lane >> 5, rl = (lane >> 4) & 1;
    const int tl = 16 * w + (lane & 15);
    const int tq = qb * 64 + tl;
    const size_t tok = (size_t)b * 4096 + tq;

    bf16x8 qf[2][4];
#define NSA_LOAD_Q() do { _Pragma("unroll") for (int tt = 0; tt < 2; ++tt) { \
        const int head = g * 4 + 2 * tt + rl; \
        const bf16_t* qp = (const bf16_t*)(ws + WS_Q) + ((size_t)(b * 8 + head) * 4096 + tq) * 64 + 8 * h5; \
        _Pragma("unroll") for (int ks = 0; ks < 4; ++ks) qf[tt][ks] = *(const bf16x8*)(qp + ks * 16); } } while (0)
    NSA_LOAD_Q();
    const int lrow = tid >> 3, lkc = (tid & 7) * 8;

    f32x16 O[2][2];
    float mrun[2], lrun[2];
#define NSA_RESET() do { _Pragma("unroll") for (int a_ = 0; a_ < 2; ++a_) { mrun[a_] = -1e30f; lrun[a_] = 0.f; _Pragma("unroll") for (int b_ = 0; b_ < 2; ++b_) O[a_][b_] = zero16(); } } while (0)

    const int jmax = (tq - 31) >> 4;
    const int n_ct = ((4 * qb + 2) >> 6) + 1;
    const bool need_sel = qb >= 16;
    const bf16_t* kcb = (const bf16_t*)(ws + WS_KCP) + (size_t)bg * 256 * 64;
    const bf16_t* vct = (const bf16_t*)(ws + WS_KCP + MiB) + (size_t)bg * 64 * 256;
    u32x4 ck0_, ck1_, cv0_, cv1_;
#define NSA_FETCH_CMP(ct) do { \
        const int j_ = tid >> 2, dq_ = (tid & 3) * 16; \
        const bf16_t* ks_ = kcb + (size_t)((ct) * 64 + j_) * 64 + dq_; \
        const bf16_t* vs_ = vct + (size_t)j_ * 256 + (ct) * 64 + dq_; \
        ck0_ = *(const u32x4*)ks_; ck1_ = *(const u32x4*)(ks_ + 8); cv0_ = *(const u32x4*)vs_; cv1_ = *(const u32x4*)(vs_ + 8); } while (0)
#define NSA_STORE_CMP() do { \
        const int j_ = tid >> 2, dq_ = (tid & 3) * 16; \
        *(u32x4*)(sK + j_ * KS72 + dq_) = ck0_; *(u32x4*)(sK + j_ * KS72 + dq_ + 8) = ck1_; \
        *(u32x4*)(sV + j_ * KS72 + dq_) = cv0_; *(u32x4*)(sV + j_ * KS72 + dq_ + 8) = cv1_; } while (0)

    NSA_RESET();
    NSA_FETCH_CMP(0);
#pragma unroll 1
    for (int ct = 0; ct < n_ct; ++ct) {
        __syncthreads();
        NSA_STORE_CMP();
        NSA_FETCH_CMP(ct + 1 < n_ct ? ct + 1 : 0);
        __syncthreads();
        const int hi = jmax - ct * 64;
#pragma unroll 1
        for (int kt2 = 0; kt2 < 2; ++kt2) {
            f32x16 st[2];
            nsa_qk(sK, kt2, qf, st, r, h5);
            nsa_softmax<false>(st, kt2, -1, hi, mrun, lrun, O, h5);
        }
    }
    float mfin[2], linv[2];
#pragma unroll
    for (int tt = 0; tt < 2; ++tt) { mfin[tt] = mrun[tt]; linv[tt] = lrun[tt] > 0.f ? 1.f / lrun[tt] : 0.f; }
#pragma unroll 1
    for (int ct = 0; ct < n_ct; ++ct) {
        __syncthreads();
        NSA_STORE_CMP();
        if (ct + 1 < n_ct) NSA_FETCH_CMP(ct + 1);
        __syncthreads();
        const int hi = jmax - ct * 64;
#pragma unroll 1
        for (int kt2 = 0; kt2 < 2; ++kt2) {
            f32x16 st[2];
            nsa_qk(sK, kt2, qf, st, r, h5);
#pragma unroll
            for (int i = 0; i < 16; ++i) {
                const int keyl = kt2 * 32 + 8 * (i >> 2) + 4 * h5 + (i & 3);
                const bool ok = keyl <= hi;
#pragma unroll
                for (int tt = 0; tt < 2; ++tt)
                    st[tt][i] = ok ? __builtin_amdgcn_exp2f(st[tt][i] - mfin[tt]) * linv[tt] : 0.f;
            }
            if (need_sel) {
#pragma unroll
                for (int c = 0; c < 4; ++c) {
                    float pt[4];
#pragma unroll
                    for (int e = 0; e < 4; ++e) { const float v = st[0][4 * c + e] + st[1][4 * c + e]; pt[e] = v + xor16f(v); }
                    if (rl == 0) {
                        const int blk = ct * 16 + kt2 * 8 + 2 * c + h5;
                        sA[tl * 65 + blk] = (pt[0] + pt[1]) + (pt[2] + pt[3]);
                        sL[tl * 65 + blk] = pt[3];
                    }
                }
            }
            nsa_pv(sV, kt2, st, O, r, h5);
        }
    }
    __syncthreads();
    const float* gatep = (const float*)(ws + WS_GATES) + tok * 24 + (g * 4 + rl) * 3;
    bf16_t* tmpO = sK + (size_t)(w * 64) * 64;
#pragma unroll
    for (int tt = 0; tt < 2; ++tt)
#pragma unroll
        for (int dt = 0; dt < 2; ++dt)
#pragma unroll
            for (int gq = 0; gq < 4; ++gq) {
                const int d0 = dt * 32 + 8 * gq + 4 * h5;
                const float gsc = gatep[tt * 6];
                *(u32x2*)(tmpO + (tt * 32 + r) * 64 + d0) = (u32x2){pk_bf16(O[dt][tt][4 * gq] * gsc, O[dt][tt][4 * gq + 1] * gsc),
                                                                    pk_bf16(O[dt][tt][4 * gq + 2] * gsc, O[dt][tt][4 * gq + 3] * gsc)};
            }
    if (need_sel) {
        const int t4 = tid >> 2, qd = tid & 3;
        float cand[16];
#pragma unroll
        for (int e = 0; e < 16; ++e) {
            const int i = 1 + qd + 4 * e;
            cand[e] = (i <= qb - 2) ? sA[t4 * 65 + i] + sL[t4 * 65 + i - 1] : -1.f;
        }
        __syncthreads();
#pragma unroll
        for (int e = 0; e < 16; ++e) { const int i = 1 + qd + 4 * e; if (i < 65) sA[t4 * 65 + i] = cand[e]; }
        __syncthreads();
        int rank[16];
#pragma unroll
        for (int e = 0; e < 16; ++e) rank[e] = 0;
#pragma unroll 1
        for (int ip = 1; ip <= qb - 2; ++ip) {
            const float v = sA[t4 * 65 + ip];
#pragma unroll
            for (int e = 0; e < 16; ++e) {
                const int i = 1 + qd + 4 * e;
                rank[e] += (v > cand[e] || (v == cand[e] && ip < i)) ? 1 : 0;
            }
        }
        unsigned lo = 0u, hi = 0u;
#pragma unroll
        for (int e = 0; e < 16; ++e) {
            const int i = 1 + qd + 4 * e;
            if (i <= qb - 2 && rank[e] < 13) { if (i < 32) lo |= 1u << i; else hi |= 1u << (i - 32); }
        }
        lo |= dpp_u<0xB1>(lo); hi |= dpp_u<0xB1>(hi);
        lo |= dpp_u<0x4E>(lo); hi |= dpp_u<0x4E>(hi);
        lo |= 1u;
        if (qb < 32) lo |= 1u << qb; else hi |= 1u << (qb - 32);
        if (qb - 1 < 32) lo |= 1u << (qb - 1); else hi |= 1u << (qb - 33);
        if (qd == 0) { sM[t4 * 2] = lo; sM[t4 * 2 + 1] = hi; }
    } else {
        if (tid < 64) {
            const unsigned long long mk = (2ull << qb) - 1ull;
            sM[tid * 2] = (unsigned)mk; sM[tid * 2 + 1] = (unsigned)(mk >> 32);
        }
    }
    __syncthreads();
    const unsigned selLo = sM[tl * 2], selHi = sM[tl * 2 + 1];
    bf16_t* myO = sO + (size_t)(w * 64) * 64;
#pragma unroll
    for (int tt = 0; tt < 2; ++tt)
#pragma unroll
        for (int q8 = 0; q8 < 4; ++q8) {
            const int off = (tt * 32 + r) * 64 + q8 * 16 + 8 * h5;
            *(u32x4*)(myO + off) = *(const u32x4*)(tmpO + off);
        }
    NSA_LOAD_Q();
    __syncthreads();

#pragma unroll 1
    for (int br = 0; br < 2; ++br) {
        const bf16_t* Kg = (const bf16_t*)(ws + (br == 0 ? WS_KS : WS_KW)) + (size_t)bg * 4096 * 64;
        const bf16_t* Vg = (const bf16_t*)(ws + (br == 0 ? WS_VST : WS_VWT)) + (size_t)bg * 64 * 4096;
        const int i_lo = (br == 0) ? 0 : (qb >= 8 ? qb - 8 : 0);
        NSA_RESET();
        u32x4 rk[2], rv[2];
#pragma unroll
        for (int i = 0; i < 2; ++i) {
            rk[i] = *(const u32x4*)(Kg + (size_t)(i_lo * 64 + lrow + 32 * i) * 64 + lkc);
            rv[i] = *(const u32x4*)(Vg + (size_t)(lrow + 32 * i) * 4096 + i_lo * 64 + lkc);
        }
#pragma unroll 1
        for (int it = i_lo; it <= qb; ++it) {
            const int buf = (it - i_lo) & 1;
            bf16_t* kb = sK + buf * 64 * KS72;
            bf16_t* vb = sV + buf * 64 * KS72;
#pragma unroll
            for (int i = 0; i < 2; ++i) {
                *(u32x4*)(kb + (lrow + 32 * i) * KS72 + lkc) = rk[i];
                *(u32x4*)(vb + (lrow + 32 * i) * KS72 + lkc) = rv[i];
            }
            __syncthreads();
            if (it < qb && variant != 3) {
#pragma unroll
                for (int i = 0; i < 2; ++i) {
                    rk[i] = *(const u32x4*)(Kg + (size_t)((it + 1) * 64 + lrow + 32 * i) * 64 + lkc);
                    rv[i] = *(const u32x4*)(Vg + (size_t)(lrow + 32 * i) * 4096 + (it + 1) * 64 + lkc);
                }
            }
            int lo = -1, hi = 63;
            if (it == qb) hi = tl;
            bool lane_ok = true;
            if (br == 0) {
                const unsigned bit = (it < 32) ? (selLo >> it) & 1u : (selHi >> (it - 32)) & 1u;
                if (!bit) { hi = -1; lane_ok = false; }
            } else {
                if (it == qb - 8) lo = tl;
            }
            const bool boundary = (it == qb) || (br == 1 && it == qb - 8);
            if (__any(hi > lo)) {
                if (boundary) {
#pragma unroll 1
                    for (int kt2 = 0; kt2 < 2; ++kt2) {
                        f32x16 st[2];
                        nsa_qk(kb, kt2, qf, st, r, h5);
                        __builtin_amdgcn_sched_barrier(0);
                        nsa_softmax<true>(st, kt2, lo, hi, mrun, lrun, O, h5);
                        __builtin_amdgcn_sched_barrier(0);
                        nsa_pv(vb, kt2, st, O, r, h5);
                        __builtin_amdgcn_sched_barrier(0);
                    }
                } else if (variant != 4) {
#pragma unroll 1
                    for (int kt2 = 0; kt2 < 2; ++kt2) {
                        f32x16 st[2];
                        nsa_qk(kb, kt2, qf, st, r, h5);
                        __builtin_amdgcn_sched_barrier(0);
                        if (variant != 2) nsa_softmax_fast(st, lane_ok, mrun, lrun, O);
                        __builtin_amdgcn_sched_barrier(0);
                        nsa_pv(vb, kt2, st, O, r, h5);
                        __builtin_amdgcn_sched_barrier(0);
                    }
                }
            }
        }
        __syncthreads();
#pragma unroll
        for (int tt = 0; tt < 2; ++tt) {
            const float gsc = gatep[tt * 6 + 1 + br] * (lrun[tt] > 0.f ? 1.f / lrun[tt] : 0.f);
#pragma unroll
            for (int dt = 0; dt < 2; ++dt)
#pragma unroll
                for (int gq = 0; gq < 4; ++gq) {
                    const int d0 = dt * 32 + 8 * gq + 4 * h5;
                    u32x2* p = (u32x2*)(myO + (tt * 32 + r) * 64 + d0);
                    const u32x2 old = *p;
                    const float v0 = bf_lo(old.x) + O[dt][tt][4 * gq] * gsc, v1 = bf_hi(old.x) + O[dt][tt][4 * gq + 1] * gsc;
                    const float v2 = bf_lo(old.y) + O[dt][tt][4 * gq + 2] * gsc, v3 = bf_hi(old.y) + O[dt][tt][4 * gq + 3] * gsc;
                    if (br == 0) {
                        *p = (u32x2){pk_bf16(v0, v1), pk_bf16(v2, v3)};
                    } else {
                        O[dt][tt][4 * gq] = v0; O[dt][tt][4 * gq + 1] = v1; O[dt][tt][4 * gq + 2] = v2; O[dt][tt][4 * gq + 3] = v3;
                    }
                }
        }
    }
    {
        bf16_t* Am = (bf16_t*)(ws + (variant ? WS_XN : WS_AMAT));
        float* ssn = (float*)(ws + (variant ? WS_X1B : WS_SSN));
#pragma unroll
        for (int tt = 0; tt < 2; ++tt) {
            const int head = g * 4 + 2 * tt + rl;
            float ss = 0.f;
            bf16_t* dst = Am + tok * 1024 + head * 64;
#pragma unroll
            for (int dt = 0; dt < 2; ++dt)
#pragma unroll
                for (int gq = 0; gq < 4; ++gq) {
                    const int d0 = dt * 32 + 8 * gq + 4 * h5;
                    const float v0 = O[dt][tt][4 * gq], v1 = O[dt][tt][4 * gq + 1], v2 = O[dt][tt][4 * gq + 2], v3 = O[dt][tt][4 * gq + 3];
                    ss += v0 * v0 + v1 * v1 + v2 * v2 + v3 * v3;
                    *(u32x2*)(dst + d0) = (u32x2){pk_bf16(v0, v1), pk_bf16(v2, v3)};
                }
            ss += xor32f(ss);
            if (h5 == 0) ssn[tok * 8 + head] = ss;
        }
    }
    __syncthreads();
#undef NSA_RESET
#undef NSA_FETCH_CMP
#undef NSA_STORE_CMP
#undef NSA_LOAD_Q
}

DEVFI void conv_item(const Params& P_, int item) {
    size_t zoff_ = 0; asm volatile("" : "+s"(zoff_)); const Params& P = *(const Params*)((const char*)&P_ + zoff_); unsigned char* ws = P.ws + zoff_;
    int tid = threadIdx.x; asm volatile("" : "+v"(tid));
    const int cc = tid & 127, rq = tid >> 7;
    const int ch = cc * 8;
    const size_t tok0 = (size_t)item * 32 + rq * 16;
    const int s0 = (int)(tok0 & 4095);
    const float* cw = P.in[11];
    const float* cb = P.in[12];
    float wv[4][8], bv[8];
#pragma unroll
    for (int j = 0; j < 4; ++j) { const f32x4 a = *(const f32x4*)(cw + j * 1024 + ch), bq = *(const f32x4*)(cw + j * 1024 + ch + 4);
        wv[j][0] = a.x; wv[j][1] = a.y; wv[j][2] = a.z; wv[j][3] = a.w; wv[j][4] = bq.x; wv[j][5] = bq.y; wv[j][6] = bq.z; wv[j][7] = bq.w; }
    { const f32x4 a = *(const f32x4*)(cb + ch), bq = *(const f32x4*)(cb + ch + 4);
        bv[0] = a.x; bv[1] = a.y; bv[2] = a.z; bv[3] = a.w; bv[4] = bq.x; bv[5] = bq.y; bv[6] = bq.z; bv[7] = bq.w; }
    const bf16_t* src = (const bf16_t*)(ws + WS_XBC) + tok0 * 1024 + ch;
    bf16_t* dst = (bf16_t*)(ws + WS_XBC2) + tok0 * 1024 + ch;
    u32x4 raw[19];
#pragma unroll
    for (int j = 0; j < 19; ++j) {
        const bool z_ = (s0 - 3 + j) < 0;
        raw[j] = z_ ? (u32x4){0u, 0u, 0u, 0u} : *(const u32x4*)(src + ((long)j - 3) * 1024);
    }
#pragma unroll
    for (int q = 0; q < 16; ++q) {
        float o[8];
#pragma unroll
        for (int e = 0; e < 8; ++e) o[e] = bv[e];
#pragma unroll
        for (int j = 0; j < 4; ++j) {
            const u32x4 rw = raw[q + j];
            o[0] += wv[j][0] * bf_lo(rw.x); o[1] += wv[j][1] * bf_hi(rw.x); o[2] += wv[j][2] * bf_lo(rw.y); o[3] += wv[j][3] * bf_hi(rw.y);
            o[4] += wv[j][4] * bf_lo(rw.z); o[5] += wv[j][5] * bf_hi(rw.z); o[6] += wv[j][6] * bf_lo(rw.w); o[7] += wv[j][7] * bf_hi(rw.w);
        }
#pragma unroll
        for (int e = 0; e < 8; ++e) o[e] = siluf_(o[e]);
        *(u32x4*)(dst + (size_t)q * 1024) = (u32x4){pk_bf16(o[0], o[1]), pk_bf16(o[2], o[3]), pk_bf16(o[4], o[5]), pk_bf16(o[6], o[7])};
    }
}

DEVFI int rot64(int pos, int row) { return (pos + 8 * (row >> 3)) & 63; }

DEVFI void ssd_item(const Params& P_, int b, int hd, unsigned char* smem) {
    size_t zoff_ = 0; asm volatile("" : "+s"(zoff_)); const Params& P = *(const Params*)((const char*)&P_ + zoff_); unsigned char* ws = P.ws + zoff_;
    int tid = threadIdx.x; asm volatile("" : "+v"(tid));
    const int lane = tid & 63, w = tid >> 6;
    const int g = hd >> 2;
    const int r = lane & 31, h5 = lane >> 5;
    bf16_t* sC = (bf16_t*)smem;
    bf16_t* sB = sC + 64 * 136;
    bf16_t* sBT = sB + 64 * 136;
    bf16_t* sXT = sBT + 128 * 72;
    bf16_t* sH = sXT + 64 * 72;
    float* sAc = (float*)(sH + 64 * 136);
    float* sDt = sAc + 64;
    const float aneg = -__expf(P.in[14][hd]);
    const float dsk = P.in[15][hd];
    const bf16_t* XB2 = (const bf16_t*)(ws + WS_XBC2);
    const bf16_t* Zb = (const bf16_t*)(ws + WS_Z);
    const float* DT = (const float*)(ws + WS_DT);
    bf16_t* Am = (bf16_t*)(ws + WS_AMAT);
    float* sss = (float*)(ws + WS_SSS);

    f32x16 hacc[2] = {zero16(), zero16()};
    for (int i = tid; i < 64 * 136 / 2; i += NTHR) ((unsigned*)sH)[i] = 0u;

    const int ccb = tid & 15, isC = (tid >> 4) & 1, rg = tid >> 5;
    const int ccx = tid & 7, rgx = tid >> 3;
    const int chBC = 512 + isC * 256 + g * 128 + ccb * 8, chX = hd * 64 + ccx * 8;
    const int lt = w & 1, ph = w >> 1;
    const int lq = lt * 32 + r;

    u32x4 rawBC[8], rawX[2];
    u32x2 zr[4];
    float dtv = 0.f;
    const int toffBC = rg * 8 * 1024 + chBC, toffX = rgx * 2 * 1024 + chX;
    const int toffZ = lq * 512 + hd * 64 + ph * 32 + 4 * h5;
#define SSD_PREFETCH(c_) do { \
        const size_t t0_ = (size_t)b * 4096 + (size_t)(c_) * 64; \
        const bf16_t* xb_ = XB2 + t0_ * 1024; \
        _Pragma("unroll") for (int j = 0; j < 8; ++j) rawBC[j] = *(const u32x4*)(xb_ + (size_t)j * 1024 + toffBC); \
        _Pragma("unroll") for (int j = 0; j < 2; ++j) rawX[j] = *(const u32x4*)(xb_ + (size_t)j * 1024 + toffX); \
        const bf16_t* zb_ = Zb + t0_ * 512 + toffZ; \
        _Pragma("unroll") for (int gq = 0; gq < 4; ++gq) zr[gq] = *(const u32x2*)(zb_ + 8 * gq); \
        dtv = DT[(t0_ + lane) * 8 + hd]; \
    } while (0)
    SSD_PREFETCH(0);

#pragma unroll 1
    for (int c = 0; c < 64; ++c) {
        const size_t tok0 = (size_t)b * 4096 + c * 64;
        if (w == 0) {
            float a = dtv * aneg;
#pragma unroll
            for (int o = 1; o < 64; o <<= 1) { const float t = __shfl_up(a, o); if (lane >= o) a += t; }
            sAc[lane] = a;
            sDt[lane] = dtv;
        }
        __syncthreads();
        const float atot = sAc[63];
#pragma unroll
        for (int q = 0; q < 8; ++q) {
            const int l = rg * 8 + q;
            const u32x4 rw = rawBC[q];
            *(u32x4*)((isC ? sC : sB) + l * 136 + ccb * 8) = rw;
            if (!isC) {
                const float wdec = __expf(atot - sAc[l]);
                const int lp = rot64((l & ~15) + perm16(l & 15), ccb * 8);
                bf16_t* d = sBT + (ccb * 8) * 72 + lp;
                d[0 * 72] = f2bf(bf_lo(rw.x) * wdec); d[1 * 72] = f2bf(bf_hi(rw.x) * wdec); d[2 * 72] = f2bf(bf_lo(rw.y) * wdec); d[3 * 72] = f2bf(bf_hi(rw.y) * wdec);
                d[4 * 72] = f2bf(bf_lo(rw.z) * wdec); d[5 * 72] = f2bf(bf_hi(rw.z) * wdec); d[6 * 72] = f2bf(bf_lo(rw.w) * wdec); d[7 * 72] = f2bf(bf_hi(rw.w) * wdec);
            }
        }
#pragma unroll
        for (int q = 0; q < 2; ++q) {
            const int l = rgx * 2 + q;
            const u32x4 rw = rawX[q];
            const float dtl = sDt[l];
            const int lp = rot64((l & ~15) + perm16(l & 15), ccx * 8);
            bf16_t* d = sXT + (ccx * 8) * 72 + lp;
            d[0 * 72] = f2bf(bf_lo(rw.x) * dtl); d[1 * 72] = f2bf(bf_hi(rw.x) * dtl); d[2 * 72] = f2bf(bf_lo(rw.y) * dtl); d[3 * 72] = f2bf(bf_hi(rw.y) * dtl);
            d[4 * 72] = f2bf(bf_lo(rw.z) * dtl); d[5 * 72] = f2bf(bf_hi(rw.z) * dtl); d[6 * 72] = f2bf(bf_lo(rw.w) * dtl); d[7 * 72] = f2bf(bf_hi(rw.w) * dtl);
        }
        u32x2 zc[4];
#pragma unroll
        for (int gq = 0; gq < 4; ++gq) zc[gq] = zr[gq];
        __syncthreads();
        if (c + 1 < 64) SSD_PREFETCH(c + 1);
        const float acl = sAc[lq];
        f32x16 y = zero16();
#pragma unroll
        for (int ks = 0; ks < 8; ++ks) {
            const bf16x8 fa = *(const bf16x8*)(sH + (ph * 32 + r) * 136 + ks * 16 + 8 * h5);
            const bf16x8 fb = *(const bf16x8*)(sC + lq * 136 + ks * 16 + 8 * h5);
            y = mfma32(fa, fb, y);
        }
        {
            const float el = __expf(acl);
#pragma unroll
            for (int i = 0; i < 16; ++i) y[i] *= el;
        }
        for (int st = 0; st <= lt; ++st) {
            f32x16 x = zero16();
#pragma unroll
            for (int ks = 0; ks < 8; ++ks) {
                const bf16x8 fa = *(const bf16x8*)(sB + (st * 32 + r) * 136 + ks * 16 + 8 * h5);
                const bf16x8 fb = *(const bf16x8*)(sC + lq * 136 + ks * 16 + 8 * h5);
                x = mfma32(fa, fb, x);
            }
#pragma unroll
            for (int i = 0; i < 16; ++i) {
                const int s_ = st * 32 + 8 * (i >> 2) + 4 * h5 + (i & 3);
                const float sg = (s_ <= lq) ? __expf(acl - sAc[s_]) : 0.f;
                x[i] *= sg;
            }
#pragma unroll
            for (int s2 = 0; s2 < 2; ++s2) {
                union { bf16x8 v; unsigned u[4]; } cv;
#pragma unroll
                for (int j = 0; j < 4; ++j) cv.u[j] = pk_bf16(x[8 * s2 + 2 * j], x[8 * s2 + 2 * j + 1]);
                const int prow = ph * 32 + r;
                const bf16x8 fa = *(const bf16x8*)(sXT + prow * 72 + rot64(st * 32 + s2 * 16 + 8 * h5, prow));
                y = mfma32(fa, cv.v, y);
            }
        }
        {
            const size_t tk = tok0 + lq;
            const float dinv = dsk * __builtin_amdgcn_rcpf(sDt[lq]);
            const int lp = (lq & ~15) + perm16(lq & 15);
            float ss = 0.f;
#pragma unroll
            for (int gq = 0; gq < 4; ++gq) {
                const int p0 = ph * 32 + 8 * gq + 4 * h5;
                const int lpr = rot64(lp, p0);
                const float z0 = bf_lo(zc[gq].x), z1 = bf_hi(zc[gq].x), z2 = bf_lo(zc[gq].y), z3 = bf_hi(zc[gq].y);
                const float v0 = (y[4 * gq] + bf2f(sXT[(p0 + 0) * 72 + lpr]) * dinv) * siluf_(z0);
                const float v1 = (y[4 * gq + 1] + bf2f(sXT[(p0 + 1) * 72 + lpr]) * dinv) * siluf_(z1);
                const float v2 = (y[4 * gq + 2] + bf2f(sXT[(p0 + 2) * 72 + lpr]) * dinv) * siluf_(z2);
                const float v3 = (y[4 * gq + 3] + bf2f(sXT[(p0 + 3) * 72 + lpr]) * dinv) * siluf_(z3);
                ss += v0 * v0 + v1 * v1 + v2 * v2 + v3 * v3;
                *(u32x2*)(Am + tk * 1024 + 512 + hd * 64 + p0) = (u32x2){pk_bf16(v0, v1), pk_bf16(v2, v3)};
            }
            ss += xor32f(ss);
            if (h5 == 0) sss[tk * 16 + hd * 2 + ph] = ss;
        }
        {
            f32x16 hn[2] = {zero16(), zero16()};
#pragma unroll
            for (int ks = 0; ks < 4; ++ks) {
                const int nrow = w * 32 + r;
                const bf16x8 fa = *(const bf16x8*)(sBT + nrow * 72 + rot64(ks * 16 + 8 * h5, nrow));
#pragma unroll
                for (int pt = 0; pt < 2; ++pt) {
                    const int prow = pt * 32 + r;
                    const bf16x8 fb = *(const bf16x8*)(sXT + prow * 72 + rot64(ks * 16 + 8 * h5, prow));
                    hn[pt] = mfma32(fa, fb, hn[pt]);
                }
            }
            const float et = __expf(atot);
#pragma unroll
            for (int pt = 0; pt < 2; ++pt)
#pragma unroll
                for (int i = 0; i < 16; ++i) hacc[pt][i] = hacc[pt][i] * et + hn[pt][i];
        }
        __syncthreads();
#pragma unroll
        for (int pt = 0; pt < 2; ++pt)
#pragma unroll
            for (int gq = 0; gq < 4; ++gq) {
                const int n0 = w * 32 + 8 * gq + 4 * h5;
                *(u32x2*)(sH + (pt * 32 + r) * 136 + n0) = (u32x2){pk_bf16(hacc[pt][4 * gq], hacc[pt][4 * gq + 1]), pk_bf16(hacc[pt][4 * gq + 2], hacc[pt][4 * gq + 3])};
            }
    }
#undef SSD_PREFETCH
    __syncthreads();
}

template <int TT> struct EpiOutProj {
    int m0, n0;
    const float* x;
    const unsigned char* xq8;
    const float* xsc;
    float* x1;
    bf16_t* x1b;
    float* ssx;
    float r01[TT], r12[TT], r2[TT];
    DEVFI void init(unsigned char* ws, int wm, int lane) {
        const float* ssn = (const float*)(ws + WS_SSN);
        const float* sss = (const float*)(ws + WS_SSS);
#pragma unroll
        for (int tt = 0; tt < TT; ++tt) {
            const size_t tok = (size_t)m0 + wm * 32 * TT + tt * 32 + (lane & 31);
            const f32x4 a0 = *(const f32x4*)(ssn + tok * 8), a1 = *(const f32x4*)(ssn + tok * 8 + 4);
            const float s0 = (a0.x + a0.y + a0.z + a0.w) + (a1.x + a1.y + a1.z + a1.w);
            const f32x4 b0 = *(const f32x4*)(sss + tok * 16), b1 = *(const f32x4*)(sss + tok * 16 + 4);
            const f32x4 b2 = *(const f32x4*)(sss + tok * 16 + 8), b3 = *(const f32x4*)(sss + tok * 16 + 12);
            const float s1 = (b0.x + b0.y + b0.z + b0.w) + (b1.x + b1.y + b1.z + b1.w);
            const float s2 = (b2.x + b2.y + b2.z + b2.w) + (b3.x + b3.y + b3.z + b3.w);
            const float q0 = rsqrtf(s0 * (1.f / 512.f) + EPS), q1 = rsqrtf(s1 * (1.f / 256.f) + EPS), q2 = rsqrtf(s2 * (1.f / 256.f) + EPS);
            r01[tt] = q0 / q1; r12[tt] = q1 / q2; r2[tt] = q2;
        }
    }
    DEVFI void hook(int kt, f32x16 (&acc)[2][TT]) const {
        if (kt == 7 || kt == 11) {
#pragma unroll
            for (int tt = 0; tt < TT; ++tt) {
                const float f = (kt == 7) ? r01[tt] : r12[tt];
#pragma unroll
                for (int ft = 0; ft < 2; ++ft)
#pragma unroll
                    for (int i = 0; i < 16; ++i) acc[ft][tt][i] *= f;
            }
        }
    }
    unsigned char* stage;
    unsigned char* x8;
    float* sx;
    DEVFI void operator()(f32x16 (&acc)[2][TT], int wm, int wn, int lane) const {
        const int h5 = lane >> 5, r = lane & 31;
        float* st = (float*)stage + (wm * 2 + wn) * (32 * 68);
        const int rrow = lane >> 4, c4 = (lane & 15) * 4;
        const int n = n0 + wn * 64 + c4;
        unsigned xv[8], xn_[8]; float xs[8], xsn_[8];
#pragma unroll
        for (int i = 0; i < 8; ++i) { const size_t t_ = (size_t)m0 + wm * 32 * TT + i * 4 + rrow; xv[i] = *(const unsigned*)(xq8 + t_ * 1024 + n); xs[i] = xsc[t_]; }
#pragma unroll
        for (int tt = 0; tt < TT; ++tt) {
            if (tt + 1 < TT) {
#pragma unroll
                for (int i = 0; i < 8; ++i) { const size_t t_ = (size_t)m0 + wm * 32 * TT + (tt + 1) * 32 + i * 4 + rrow; xn_[i] = *(const unsigned*)(xq8 + t_ * 1024 + n); xsn_[i] = xsc[t_]; }
            }
#pragma unroll
            for (int ft = 0; ft < 2; ++ft)
#pragma unroll
                for (int gq = 0; gq < 4; ++gq) {
                    f32x4 v;
#pragma unroll
                    for (int e = 0; e < 4; ++e) v[e] = acc[ft][tt][4 * gq + e] * r2[tt];
                    *(f32x4*)(st + r * 68 + ft * 32 + 8 * gq + 4 * h5) = v;
                }
            float ssk = 0.f, amk = 0.f;
#pragma unroll
            for (int i = 0; i < 8; ++i) {
                const int row = i * 4 + rrow;
                const size_t tok = (size_t)m0 + wm * 32 * TT + tt * 32 + row;
                const f32x4 a = *(const f32x4*)(st + row * 68 + c4);
                const f32x4 y = (f32x4){a.x + (float)(signed char)(xv[i] & 255u) * xs[i], a.y + (float)(signed char)((xv[i] >> 8) & 255u) * xs[i],
                                        a.z + (float)(signed char)((xv[i] >> 16) & 255u) * xs[i], a.w + (float)(signed char)(xv[i] >> 24) * xs[i]};
                *(u32x2*)(x1b + tok * 1024 + n) = (u32x2){pk_bf16(y.x, y.y), pk_bf16(y.z, y.w)};
                const float ss = row16_sum((y.x * y.x + y.y * y.y) + (y.z * y.z + y.w * y.w));
                const float am = row16_max(fmaxf(fmaxf(fabsf(y.x), fabsf(y.y)), fmaxf(fabsf(y.z), fabsf(y.w))));
                const float qs = am > 0.f ? 7.f * __builtin_amdgcn_rcpf(am) : 0.f;
                const int q0 = (int)rintf(y.x * qs), q1 = (int)rintf(y.y * qs), q2 = (int)rintf(y.z * qs), q3 = (int)rintf(y.w * qs);
                *(unsigned short*)(x8 + tok * 512 + (n >> 1)) = (unsigned short)(((unsigned)q0 & 15u) | (((unsigned)q1 & 15u) << 4) | (((unsigned)q2 & 15u) << 8) | (((unsigned)q3 & 15u) << 12));
                if ((lane & 15) == i) { ssk = ss; amk = am; }
            }
            if ((lane & 15) < 8) {
                const size_t tok = (size_t)m0 + wm * 32 * TT + tt * 32 + (lane & 15) * 4 + rrow;
                ssx[tok * 16 + (n0 >> 7) * 2 + wn] = ssk; sx[tok * 16 + (n0 >> 7) * 2 + wn] = amk * (1.f / 7.f);
            }
            if (tt + 1 < TT) {
#pragma unroll
                for (int i = 0; i < 8; ++i) { xv[i] = xn_[i]; xs[i] = xsn_[i]; }
            }
        }
    }
};

DEVFI void copy_x1(const Params& P_) {
    size_t zoff_ = 0; asm volatile("" : "+s"(zoff_)); const Params& P = *(const Params*)((const char*)&P_ + zoff_);
    const int bid = blockIdx.x, nb = gridDim.x, tid = threadIdx.x, lane = tid & 63, w = tid >> 6;
    const float* x = P.in[0];
    bf16_t* x1b = (bf16_t*)(P.ws + WS_X1B);
    float* ssx = (float*)(P.ws + WS_SSX);
    for (int row = bid * 4 + w; row < T; row += nb * 4) {
        const f32x4* xr = (const f32x4*)(x + (size_t)row * D) + lane;
        f32x4* o1 = (f32x4*)(P.out + (size_t)row * D) + lane;
        u32x2* o2 = (u32x2*)(x1b + (size_t)row * D) + lane;
        float ss = 0.f;
#pragma unroll
        for (int j = 0; j < 4; ++j) {
            const f32x4 v = xr[64 * j];
            ss += v.x * v.x + v.y * v.y + v.z * v.z + v.w * v.w;
            o1[64 * j] = v;
            o2[64 * j] = (u32x2){pk_bf16(v.x, v.y), pk_bf16(v.z, v.w)};
        }
        ss = wave_sum(ss);
        if (lane < 16) ssx[(size_t)row * 16 + lane] = lane == 0 ? ss : 0.f;
    }
}

DEVFI float fmax_raw(float a, float b) { float r; asm("v_max_f32 %0, %1, %2" : "=v"(r) : "v"(a), "v"(b)); return r; }
DEVFI float fmin_raw(float a, float b) { float r; asm("v_min_f32 %0, %1, %2" : "=v"(r) : "v"(a), "v"(b)); return r; }
#define CE_DESC(x_, y_) do { const float mx_ = fmax_raw(x_, y_), mn_ = fmin_raw(x_, y_); x_ = mx_; y_ = mn_; } while (0)
__host__ __device__ constexpr int s16A(int i) {
    constexpr signed char t[60] = {0,1,2,3,4,5,7,9,0,1,2,3,6,8,10,11,0,2,4,6,7,10,12,14,0,1,4,5,6,8,12,13,1,3,4,5,8,9,13,1,2,5,7,9,11,2,3,9,11,3,6,7,10,3,5,7,9,11,6,8};
    return t[i];
}
__host__ __device__ constexpr int s16B(int i) {
    constexpr signed char t[60] = {13,12,15,14,8,6,11,10,5,7,9,4,13,14,15,12,1,3,5,8,9,11,13,15,2,3,10,11,7,9,14,15,2,12,6,7,10,11,14,4,6,8,10,13,14,4,6,12,13,5,8,9,12,4,6,8,10,12,7,9};
    return t[i];
}
template <int C> DEVFI void s16_step(float (&k)[16]) { constexpr int a = s16A(C), b = s16B(C); CE_DESC(k[a], k[b]); }
template <int... Cs> DEVFI void s16_run(float (&k)[16], std::integer_sequence<int, Cs...>) { (s16_step<Cs>(k), ...); }
DEVFI void sort16_desc(float (&k)[16]) { s16_run(k, std::make_integer_sequence<int, 60>{}); }
DEVFI void bitonic_merge16_desc(float (&c)[16]) {
#pragma unroll
    for (int st = 8; st > 0; st >>= 1)
#pragma unroll
        for (int i = 0; i < 16; ++i) {
            const int j = i ^ st;
            if (j > i) CE_DESC(c[i], c[j]);
        }
}
DEVFI void merge16_inlane(float (&run)[16], const float (&oth)[16]) {
    float c[16];
#pragma unroll
    for (int i = 0; i < 16; ++i) c[i] = fmax_raw(run[i], oth[15 - i]);
    bitonic_merge16_desc(c);
#pragma unroll
    for (int i = 0; i < 16; ++i) run[i] = c[i];
}
DEVFI void merge16_x32(float (&k)[16]) {
    float lo[16], hi[16];
#pragma unroll
    for (int i = 0; i < 16; ++i) {
#if __has_builtin(__builtin_amdgcn_permlane32_swap)
        const unsigned u = __float_as_uint(k[i]);
        const auto pr = __builtin_amdgcn_permlane32_swap(u, u, false, false);
        lo[i] = __uint_as_float(pr[0]); hi[i] = __uint_as_float(pr[1]);
#else
        const float o = __shfl_xor(k[i], 32);
        lo[i] = (threadIdx.x & 32) ? o : k[i]; hi[i] = (threadIdx.x & 32) ? k[i] : o;
#endif
    }
    float c[16];
#pragma unroll
    for (int i = 0; i < 16; ++i) c[i] = fmax_raw(lo[i], hi[15 - i]);
    bitonic_merge16_desc(c);
#pragma unroll
    for (int i = 0; i < 16; ++i) k[i] = c[i];
}
struct EpiRoute {
    float top[2][16];
    DEVFI void hook(int, f32x16 (&)[4][2]) const {}
    DEVFI void operator()(f32x16 (&acc)[4][2], int wm, int wn, int lane) {
        const unsigned hb = (lane & 32) ? 0u : 4u;
#pragma unroll
        for (int tt = 0; tt < 2; ++tt) {
#pragma unroll
            for (int ft = 0; ft < 4; ++ft) {
                float k16[16];
#pragma unroll
                for (int i = 0; i < 16; ++i) {
                    const unsigned cb = (~(unsigned)(ft * 32 + 8 * (i >> 2) + (i & 3))) & 0x7Bu;
                    k16[i] = __uint_as_float((__float_as_uint(acc[ft][tt][i]) & ~0x7Fu) | hb | cb);
                }
                sort16_desc(k16);
                if (ft == 0) {
#pragma unroll
                    for (int i = 0; i < 16; ++i) top[tt][i] = k16[i];
                } else merge16_inlane(top[tt], k16);
            }
            merge16_x32(top[tt]);
        }
    }
};
__host__ __device__ constexpr int cellA(int i) {
    constexpr signed char t[64] = {0,0,0,0,0,0,0,0,0,0,0,0,0,0,0,0, 1,1,1,1,1,1,1,1,2,2,2,2,2,3,3,3, 3,4,4,4,5,5,6,6,7,7,8,9,10,11,12,13, 14,15,-1,-1,-1,-1,-1,-1,-1,-1,-1,-1,-1,-1,-1,-1};
    return t[i];
}
__host__ __device__ constexpr int cellB(int i) {
    constexpr signed char t[64] = {0,1,2,3,4,5,6,7,8,9,10,11,12,13,14,15, 0,1,2,3,4,5,6,7,0,1,2,3,4,0,1,2, 3,0,1,2,0,1,0,1,0,1,0,0,0,0,0,0, 0,0,0,0,0,0,0,0,0,0,0,0,0,0,0,0};
    return t[i];
}
template <int GI>
DEVFI void cand_group(const float (&v1)[16], const float (&v2)[16], float (&ck)[16]) {
#define CG_(e) { constexpr int ca = cellA(GI * 16 + (e)), cb = cellB(GI * 16 + (e)); \
        if constexpr (ca >= 0) ck[e] = __uint_as_float((__float_as_uint(v1[ca] + v2[cb]) & ~0xFFu) | (unsigned)(255 - (ca * 16 + cb))); \
        else ck[e] = -__builtin_inff(); }
    CG_(0) CG_(1) CG_(2) CG_(3) CG_(4) CG_(5) CG_(6) CG_(7) CG_(8) CG_(9) CG_(10) CG_(11) CG_(12) CG_(13) CG_(14) CG_(15)
#undef CG_
}

DEVFI void peer_route_item(const Params& P_, int item, unsigned char* smem, const int rot_, const int nk_ = 16) {
    size_t zoff_ = 0; asm volatile("" : "+s"(zoff_)); const Params& P = *(const Params*)((const char*)&P_ + zoff_); unsigned char* ws = P.ws + zoff_;
    int tid = threadIdx.x; asm volatile("" : "+v"(tid));
    const int lane = tid & 63, wid = __builtin_amdgcn_readfirstlane(tid >> 6), h5 = lane >> 5;
    const int wm = wid >> 1, wn = wid & 1;
    const int mt = item >> 3, hh = item & 7;
    const size_t tok = (size_t)mt * 128 + wm * 64 + wn * 32 + (lane & 31);
    EpiRoute er;
    gemm_tile3_i8<4, 2>(ws + WS_X8T + (size_t)mt * 128 * 1024, 1024, ws + WS_WQ8 + (size_t)(hh * 2) * 128 * 1024, 1024, nk_,
                        (const float*)(ws + WS_QF) + mt * 128, (const float*)(ws + WS_SWQ) + hh * 256, smem, er);
    float* xl = (float*)smem;
    if (h5 == 0) {
#pragma unroll
        for (int i = 0; i < 16; ++i) xl[((wid * 2 + (1 - wn)) * 16 + i) * 32 + lane] = wn ? er.top[0][i] : er.top[1][i];
    }
    __syncthreads();
    float t0[16], t1[16];
#pragma unroll
    for (int i = 0; i < 16; ++i) {
        const float own = wn ? er.top[1][i] : er.top[0][i];
        const float oth = xl[(((wm * 2 + (1 - wn)) * 2 + wn) * 16 + i) * 32 + (lane & 31)];
        t0[i] = wn ? oth : own; t1[i] = wn ? own : oth;
    }
    __syncthreads();
    float v1[16], v2[16];
#pragma unroll
    for (int i = 0; i < 16; ++i) { v1[i] = __uint_as_float(__float_as_uint(t0[i]) & ~0x7Fu); v2[i] = __uint_as_float(__float_as_uint(t1[i]) & ~0x7Fu); }
    float run[16];
    {
        float ck[16];
        cand_group<0>(v1, v2, run); sort16_desc(run);
        cand_group<1>(v1, v2, ck); sort16_desc(ck); merge16_inlane(run, ck);
        cand_group<2>(v1, v2, ck); sort16_desc(ck); merge16_inlane(run, ck);
        cand_group<3>(v1, v2, ck); sort16_desc(ck); merge16_inlane(run, ck);
    }
    unsigned char* tab = smem + 65536 + wid * 1024 + (lane & 31) * 32;
    {
        unsigned pa[4], pb[4];
#pragma unroll
        for (int q = 0; q < 4; ++q) {
            unsigned wa = 0u, wb = 0u;
#pragma unroll
            for (int e = 0; e < 4; ++e) { wa |= (127u - (__float_as_uint(t0[4 * q + e]) & 0x7Fu)) << (8 * e); wb |= (127u - (__float_as_uint(t1[4 * q + e]) & 0x7Fu)) << (8 * e); }
            pa[q] = wa; pb[q] = wb;
        }
        if (h5 == 0) *(u32x4*)tab = (u32x4){pa[0], pa[1], pa[2], pa[3]};
        else *(u32x4*)(tab + 16) = (u32x4){pb[0], pb[1], pb[2], pb[3]};
    }
    float val[16]; int eidx[16];
    const float vmax = __uint_as_float(__float_as_uint(run[0]) & ~0xFFu);
    float sum = 0.f;
#pragma unroll
    for (int j = 0; j < 16; ++j) {
        const int flat = 255 - (int)(__float_as_uint(run[j]) & 0xFFu);
        const int ca = flat >> 4, cb = flat & 15;
        eidx[j] = (int)tab[ca] * 128 + (int)tab[16 + cb];
        val[j] = __expf(__uint_as_float(__float_as_uint(run[j]) & ~0xFFu) - vmax);
        sum += val[j];
    }
    const float inv = 1.f / sum;
    unsigned short* oi = (unsigned short*)(ws + WS_IDX) + tok * 128 + hh * 16 + h5 * 8;
    float* og = (float*)(ws + WS_GATE) + tok * 128 + hh * 16 + h5 * 8;
    if (h5 == 0) {
        *(u32x4*)oi = (u32x4){(unsigned)eidx[0] | ((unsigned)eidx[1] << 16), (unsigned)eidx[2] | ((unsigned)eidx[3] << 16),
                              (unsigned)eidx[4] | ((unsigned)eidx[5] << 16), (unsigned)eidx[6] | ((unsigned)eidx[7] << 16)};
        *(f32x4*)og = (f32x4){val[0] * inv, val[1] * inv, val[2] * inv, val[3] * inv};
        *(f32x4*)(og + 4) = (f32x4){val[4] * inv, val[5] * inv, val[6] * inv, val[7] * inv};
    } else {
        *(u32x4*)oi = (u32x4){(unsigned)eidx[8] | ((unsigned)eidx[9] << 16), (unsigned)eidx[10] | ((unsigned)eidx[11] << 16),
                              (unsigned)eidx[12] | ((unsigned)eidx[13] << 16), (unsigned)eidx[14] | ((unsigned)eidx[15] << 16)};
        *(f32x4*)og = (f32x4){val[8] * inv, val[9] * inv, val[10] * inv, val[11] * inv};
        *(f32x4*)(og + 4) = (f32x4){val[12] * inv, val[13] * inv, val[14] * inv, val[15] * inv};
    }
}

constexpr size_t WS_C = WS_XN;
constexpr size_t WS_PART = WS_XBC;
constexpr size_t WS_YB = WS_AMAT;
DEVFI void peer_u_task(unsigned char* ws, size_t tok0, int q, int lane, int* wl  ) {
    const int ts = lane >> 3, ch = lane & 7;
    const size_t tok = tok0 + ts;
    const int b0 = lane & 1, b1 = (lane >> 1) & 1, b2 = (lane >> 2) & 1;
    const int sl = q & 3;
    const u32x4 xq = *(const u32x4*)(ws + WS_X8 + tok * 512 + sl * 128 + ch * 16);
    const float sxl = ((const float*)(ws + WS_SX))[tok * 16 + sl * 4 + (ch >> 1)];
    const unsigned short* ip = (const unsigned short*)(ws + WS_IDX) + tok * 128;
    const unsigned char* ub = ws + WS_U + (size_t)sl * (16384 * 128) + ch * 16;
    unsigned* pp = (unsigned*)(ws + WS_PART) + ((size_t)sl * T + tok) * 64;
    {
#pragma unroll
        for (int k = 0; k < 2; ++k) {
            const u32x4 v_ = *(const u32x4*)(ip + ch * 16 + 8 * k);
            *(u32x4*)(wl + lane * 16 + 8 * k) = (u32x4){v_.x & 0xFFFFu, v_.x >> 16, v_.y & 0xFFFFu, v_.y >> 16};
            *(u32x4*)(wl + lane * 16 + 8 * k + 4) = (u32x4){v_.z & 0xFFFFu, v_.z >> 16, v_.w & 0xFFFFu, v_.w >> 16};
        }
    }
    const int* lid = wl + ts * 128;
    u32x4 ua[8], ubuf[8];
#define PU_ISSUE(dst, hs_) do { const u32x4 e0_ = *(const u32x4*)(lid + (hs_) * 8), e1_ = *(const u32x4*)(lid + (hs_) * 8 + 4); \
        dst[0] = *(const u32x4*)(ub + (size_t)e0_.x * 128); dst[1] = *(const u32x4*)(ub + (size_t)e0_.y * 128); \
        dst[2] = *(const u32x4*)(ub + (size_t)e0_.z * 128); dst[3] = *(const u32x4*)(ub + (size_t)e0_.w * 128); \
        dst[4] = *(const u32x4*)(ub + (size_t)e1_.x * 128); dst[5] = *(const u32x4*)(ub + (size_t)e1_.y * 128); \
        dst[6] = *(const u32x4*)(ub + (size_t)e1_.z * 128); dst[7] = *(const u32x4*)(ub + (size_t)e1_.w * 128); } while (0)
#define PU_DOT(src, dd, off) do { _Pragma("unroll") for (int p = 0; p < 8; ++p) { \
        int is_ = __builtin_amdgcn_sdot8((int)src[p][0], (int)xq.x, 0, false); \
        is_ = __builtin_amdgcn_sdot8((int)src[p][1], (int)xq.y, is_, false); \
        is_ = __builtin_amdgcn_sdot8((int)src[p][2], (int)xq.z, is_, false); \
        is_ = __builtin_amdgcn_sdot8((int)src[p][3], (int)xq.w, is_, false); \
        dd[(off) + p] = (float)is_ * sxl; } } while (0)
    PU_ISSUE(ua, 0);
#pragma unroll 1
    for (int blk = 0; blk < 8; ++blk) {
        float d[16];
        PU_ISSUE(ubuf, 2 * blk + 1);
        PU_DOT(ua, d, 0);
        if (blk < 7) PU_ISSUE(ua, 2 * blk + 2);
        PU_DOT(ubuf, d, 8);
        float d8[8], d4[4], d2[2];
#pragma unroll
        for (int i = 0; i < 8; ++i) { const float keep = b2 ? d[i + 8] : d[i], send = b2 ? d[i] : d[i + 8]; d8[i] = keep + xor4f(send); }
#pragma unroll
        for (int i = 0; i < 4; ++i) { const float keep = b1 ? d8[i + 4] : d8[i], send = b1 ? d8[i] : d8[i + 4]; d4[i] = keep + xor2f(send); }
#pragma unroll
        for (int i = 0; i < 2; ++i) { const float keep = b0 ? d4[i + 2] : d4[i], send = b0 ? d4[i] : d4[i + 2]; d2[i] = keep + xor1f(send); }
        pp[blk * 8 + 4 * b2 + 2 * b1 + b0] = pk_bf16(d2[0], d2[1]);
    }
#undef PU_ISSUE
#undef PU_DOT
}
DEVFI void peer_c_tokens4(unsigned char* ws, size_t tok0, int lane) {
    const float* SU = (const float*)(ws + WS_SU);
    const float* SV = (const float*)(ws + WS_SV);
    unsigned ids[4]; f32x2 gt[4]; unsigned pv[4][4]; f32x4 sq4[4];
#pragma unroll
    for (int t = 0; t < 4; ++t) {
        const size_t tok = tok0 + t;
        ids[t] = *((const unsigned*)(ws + WS_IDX) + tok * 64 + lane);
        gt[t] = *(const f32x2*)((const float*)(ws + WS_GATE) + tok * 128 + 2 * lane);
        const unsigned* pp = (const unsigned*)(ws + WS_PART) + tok * 64 + lane;
#pragma unroll
        for (int q = 0; q < 4; ++q) pv[t][q] = pp[(size_t)q * T * 64];
        sq4[t] = *(const f32x4*)((const float*)(ws + WS_SSX) + tok * 16 + (lane & 3) * 4);
    }
    float su0[4], su1[4], sv0[4], sv1[4];
#pragma unroll
    for (int t = 0; t < 4; ++t) {
        const int e0 = (int)(ids[t] & 0xFFFFu), e1 = (int)(ids[t] >> 16);
        su0[t] = SU[e0]; su1[t] = SU[e1]; sv0[t] = SV[e0]; sv1[t] = SV[e1];
    }
#pragma unroll
    for (int t = 0; t < 4; ++t) {
        float sq = (sq4[t].x + sq4[t].y) + (sq4[t].z + sq4[t].w);
        sq += xor1f(sq); sq += xor2f(sq);
        const float rs = rsqrtf(sq * (1.f / 1024.f) + EPS);
        float d0 = 0.f, d1 = 0.f;
#pragma unroll
        for (int q = 0; q < 4; ++q) { d0 += bf_lo(pv[t][q]); d1 += bf_hi(pv[t][q]); }
        *((unsigned*)(ws + WS_C) + (tok0 + t) * 64 + lane) = pk_bf16(gt[t].x * sv0[t] * gelu_tanh(d0 * rs * su0[t]), gt[t].y * sv1[t] * gelu_tanh(d1 * rs * su1[t]));
    }
}
typedef _Float16 h2v __attribute__((ext_vector_type(2)));
DEVFI void peer_v_task(const Params& P, unsigned char* ws, size_t tok0, int q, int lane, const bool dry, int* wl  ) {
    const int ts = lane >> 3, ch = lane & 7;
    const size_t tok = tok0 + ts;
    const unsigned short* ip = (const unsigned short*)(ws + WS_IDX) + tok * 128;
    const bf16_t* cp = (const bf16_t*)(ws + WS_C) + tok * 128;
    const int sl = q & 3;
    const unsigned char* vb = ws + WS_V + (size_t)sl * (16384 * 128) + ch * 16;
    h2v acc[16];
#pragma unroll
    for (int j = 0; j < 16; ++j) acc[j] = (h2v){(_Float16)0, (_Float16)0};
    {
#pragma unroll
        for (int k = 0; k < 2; ++k) {
            const u32x4 v_ = *(const u32x4*)(ip + ch * 16 + 8 * k);
            *(u32x4*)(wl + lane * 16 + 8 * k) = (u32x4){v_.x & 0xFFFFu, v_.x >> 16, v_.y & 0xFFFFu, v_.y >> 16};
            *(u32x4*)(wl + lane * 16 + 8 * k + 4) = (u32x4){v_.z & 0xFFFFu, v_.z >> 16, v_.w & 0xFFFFu, v_.w >> 16};
        }
#pragma unroll
        for (int k = 0; k < 2; ++k) {
            const u32x4 c_ = *(const u32x4*)(cp + ch * 16 + 8 * k);
            *(f32x4*)((float*)wl + 1024 + lane * 16 + 8 * k) = (f32x4){bf_lo(c_.x), bf_hi(c_.x), bf_lo(c_.y), bf_hi(c_.y)};
            *(f32x4*)((float*)wl + 1024 + lane * 16 + 8 * k + 4) = (f32x4){bf_lo(c_.z), bf_hi(c_.z), bf_lo(c_.w), bf_hi(c_.w)};
        }
    }
    const int* lid = wl + ts * 128;
    const float* lcf = (const float*)wl + 1024 + ts * 128;
    u32x4 va[8], vbuf[8];
#define PV_ISSUE(dst, hs_) do { const u32x4 e0_ = *(const u32x4*)(lid + (hs_) * 8), e1_ = *(const u32x4*)(lid + (hs_) * 8 + 4); \
        dst[0] = *(const u32x4*)(vb + (size_t)e0_.x * 128); dst[1] = *(const u32x4*)(vb + (size_t)e0_.y * 128); \
        dst[2] = *(const u32x4*)(vb + (size_t)e0_.z * 128); dst[3] = *(const u32x4*)(vb + (size_t)e0_.w * 128); \
        dst[4] = *(const u32x4*)(vb + (size_t)e1_.x * 128); dst[5] = *(const u32x4*)(vb + (size_t)e1_.y * 128); \
        dst[6] = *(const u32x4*)(vb + (size_t)e1_.z * 128); dst[7] = *(const u32x4*)(vb + (size_t)e1_.w * 128); } while (0)
#define PV_FMA(src, hs_) do { const f32x4 c0_ = *(const f32x4*)(lcf + (hs_) * 8), c1_ = *(const f32x4*)(lcf + (hs_) * 8 + 4); \
        _Pragma("unroll") for (int p = 0; p < 8; ++p) { const float c_ = (p < 4) ? c0_[p & 3] : c1_[p & 3]; \
        const h2v c2 = __builtin_bit_cast(h2v, __builtin_amdgcn_cvt_pkrtz(c_, c_)); \
        _Pragma("unroll") for (int k = 0; k < 4; ++k) { \
            acc[4 * k] = __builtin_amdgcn_cvt_scalef32_pk_f16_fp4(src[p][k], 1.0f, 0) * c2 + acc[4 * k]; \
            acc[4 * k + 1] = __builtin_amdgcn_cvt_scalef32_pk_f16_fp4(src[p][k], 1.0f, 1) * c2 + acc[4 * k + 1]; \
            acc[4 * k + 2] = __builtin_amdgcn_cvt_scalef32_pk_f16_fp4(src[p][k], 1.0f, 2) * c2 + acc[4 * k + 2]; \
            acc[4 * k + 3] = __builtin_amdgcn_cvt_scalef32_pk_f16_fp4(src[p][k], 1.0f, 3) * c2 + acc[4 * k + 3]; } } } while (0)
    PV_ISSUE(va, 0);
#pragma unroll 1
    for (int hs = 0; hs < 16; hs += 2) {
        PV_ISSUE(vbuf, hs + 1);
        PV_FMA(va, hs);
        if (hs < 14) PV_ISSUE(va, hs + 2);
        PV_FMA(vbuf, hs + 1);
    }
#undef PV_ISSUE
#undef PV_FMA
    const bf16_t* xrow = (const bf16_t*)(ws + WS_X1B) + tok * 1024 + sl * 256 + ch * 32;
    bf16_t* yrow = (bf16_t*)(ws + (dry ? WS_Q : WS_YB)) + (dry ? (tok & 8191) : tok) * 1024 + sl * 256 + ch * 32;
    u32x4 xv[4];
#pragma unroll
    for (int j = 0; j < 4; ++j) xv[j] = *(const u32x4*)(xrow + 8 * j);
#pragma unroll
    for (int j = 0; j < 4; ++j)
        *(u32x4*)(yrow + 8 * j) = (u32x4){pk_bf16(bf_lo(xv[j].x) + (float)acc[4 * j].x, bf_hi(xv[j].x) + (float)acc[4 * j].y), pk_bf16(bf_lo(xv[j].y) + (float)acc[4 * j + 1].x, bf_hi(xv[j].y) + (float)acc[4 * j + 1].y),
                                  pk_bf16(bf_lo(xv[j].z) + (float)acc[4 * j + 2].x, bf_hi(xv[j].z) + (float)acc[4 * j + 2].y), pk_bf16(bf_lo(xv[j].w) + (float)acc[4 * j + 3].x, bf_hi(xv[j].w) + (float)acc[4 * j + 3].y)};
}
DEVFI void final_norm_tokens4(const Params& P, size_t tok0, int lane) {
    const float* fg = P.in[24] + lane * 16;
    u32x4 a[4], b[4];
#pragma unroll
    for (int t = 0; t < 4; ++t) {
        const bf16_t* yb = (const bf16_t*)(P.ws + WS_YB) + (tok0 + t) * 1024 + lane * 16;
        a[t] = *(const u32x4*)yb; b[t] = *(const u32x4*)(yb + 8);
    }
    f32x4 gk[4];
#pragma unroll
    for (int k = 0; k < 4; ++k) gk[k] = *(const f32x4*)(fg + 4 * k);
#pragma unroll
    for (int t = 0; t < 4; ++t) {
        float* orow = P.out + (tok0 + t) * 1024 + lane * 16;
        f32x4 y[4] = {(f32x4){bf_lo(a[t].x), bf_hi(a[t].x), bf_lo(a[t].y), bf_hi(a[t].y)}, (f32x4){bf_lo(a[t].z), bf_hi(a[t].z), bf_lo(a[t].w), bf_hi(a[t].w)},
                      (f32x4){bf_lo(b[t].x), bf_hi(b[t].x), bf_lo(b[t].y), bf_hi(b[t].y)}, (f32x4){bf_lo(b[t].z), bf_hi(b[t].z), bf_lo(b[t].w), bf_hi(b[t].w)}};
        float ss = 0.f;
#pragma unroll
        for (int k = 0; k < 4; ++k) ss += y[k].x * y[k].x + y[k].y * y[k].y + y[k].z * y[k].z + y[k].w * y[k].w;
        ss = wave_sum(ss);
        const float rf = rsqrtf(ss * (1.f / 1024.f) + EPS);
#pragma unroll
        for (int k = 0; k < 4; ++k)
            *(f32x4*)(orow + 4 * k) = (f32x4){y[k].x * rf * gk[k].x, y[k].y * rf * gk[k].y, y[k].z * rf * gk[k].z, y[k].w * rf * gk[k].w};
    }
}

DEVFI void wq_quant_row(unsigned char* ws, int row, int lane) {
    const bf16_t* src = (const bf16_t*)(ws + WS_WQ) + (size_t)row * 1024 + lane * 16;
    const u32x4 a = *(const u32x4*)src, b = *(const u32x4*)(src + 8);
    float v[16] = {bf_lo(a.x), bf_hi(a.x), bf_lo(a.y), bf_hi(a.y), bf_lo(a.z), bf_hi(a.z), bf_lo(a.w), bf_hi(a.w),
                   bf_lo(b.x), bf_hi(b.x), bf_lo(b.y), bf_hi(b.y), bf_lo(b.z), bf_hi(b.z), bf_lo(b.w), bf_hi(b.w)};
    float am = 0.f;
#pragma unroll
    for (int j = 0; j < 16; ++j) am = fmaxf(am, fabsf(v[j]));
    am = wave_max(am);
    const float qs = am > 0.f ? 127.f / am : 0.f;
    unsigned o[4];
#pragma unroll
    for (int q = 0; q < 4; ++q) {
        const int q0 = (int)rintf(v[4 * q] * qs), q1 = (int)rintf(v[4 * q + 1] * qs), q2 = (int)rintf(v[4 * q + 2] * qs), q3 = (int)rintf(v[4 * q + 3] * qs);
        o[q] = ((unsigned)q0 & 255u) | (((unsigned)q1 & 255u) << 8) | (((unsigned)q2 & 255u) << 16) | (((unsigned)q3 & 255u) << 24);
    }
    *(u32x4*)(ws + WS_WQ8 + (size_t)row * 1024 + lane * 16) = (u32x4){o[0], o[1], o[2], o[3]};
    if (lane == 0) ((float*)(ws + WS_SWQ))[row] = am * (1.f / 127.f);
}
DEVFI void x1_requant_tokens4(unsigned char* ws, size_t tok0, int lane) {
    u32x4 a[4], b[4]; f32x4 sx4[4], ss4[4];
#pragma unroll
    for (int t = 0; t < 4; ++t) {
        const bf16_t* xr = (const bf16_t*)(ws + WS_X1B) + (tok0 + t) * 1024 + lane * 16;
        a[t] = *(const u32x4*)xr; b[t] = *(const u32x4*)(xr + 8);
        sx4[t] = *(const f32x4*)((const float*)(ws + WS_SX) + (tok0 + t) * 16 + (lane & 3) * 4);
        ss4[t] = *(const f32x4*)((const float*)(ws + WS_SSX) + (tok0 + t) * 16 + (lane & 3) * 4);
    }
#pragma unroll
    for (int t = 0; t < 4; ++t) {
        float am = fmaxf(fmaxf(sx4[t].x, sx4[t].y), fmaxf(sx4[t].z, sx4[t].w));
        am = fmaxf(am, xor1f(am)); am = fmaxf(am, xor2f(am));
        am *= 7.f;
        float sq = (ss4[t].x + ss4[t].y) + (ss4[t].z + ss4[t].w);
        sq += xor1f(sq); sq += xor2f(sq);
        const float rs = rsqrtf(sq * (1.f / 1024.f) + EPS);
        const float qs = am > 0.f ? 127.f / am : 0.f;
        const float v[16] = {bf_lo(a[t].x), bf_hi(a[t].x), bf_lo(a[t].y), bf_hi(a[t].y), bf_lo(a[t].z), bf_hi(a[t].z), bf_lo(a[t].w), bf_hi(a[t].w),
                             bf_lo(b[t].x), bf_hi(b[t].x), bf_lo(b[t].y), bf_hi(b[t].y), bf_lo(b[t].z), bf_hi(b[t].z), bf_lo(b[t].w), bf_hi(b[t].w)};
        unsigned o[4];
#pragma unroll
        for (int q = 0; q < 4; ++q) {
            const int q0 = (int)rintf(v[4 * q] * qs), q1 = (int)rintf(v[4 * q + 1] * qs), q2 = (int)rintf(v[4 * q + 2] * qs), q3 = (int)rintf(v[4 * q + 3] * qs);
            o[q] = ((unsigned)q0 & 255u) | (((unsigned)q1 & 255u) << 8) | (((unsigned)q2 & 255u) << 16) | (((unsigned)q3 & 255u) << 24);
        }
        *(u32x4*)(ws + WS_X8T + (tok0 + t) * 1024 + lane * 16) = (u32x4){o[0], o[1], o[2], o[3]};
        if (lane == 0) ((float*)(ws + WS_QF))[tok0 + t] = rs * am * (1.f / 127.f);
    }
}

#define XB_TMO      128
#define XB_XCNT(j)  (256  + 64 * (j))
#define XB_XSUB(j)  (1280 + 64 * (j))
#define XB_XGEN(j)  (2304 + 64 * (j))
#define XB_TOP      3328
#define XB_TOPGEN   3392
#define XCD_BAR_WORDS 3456
#define XB_SPIN_CAP (1u << 18)
#define LAS __attribute__((address_space(3)))
DEVFI unsigned xb_ld(unsigned* p)              { return __hip_atomic_load(p, __ATOMIC_RELAXED, __HIP_MEMORY_SCOPE_AGENT); }
DEVFI unsigned xb_add(unsigned* p, unsigned v) { return __hip_atomic_fetch_add(p, v, __ATOMIC_RELAXED, __HIP_MEMORY_SCOPE_AGENT); }
DEVFI unsigned xb_xcc_id() { return (unsigned)__builtin_amdgcn_s_getreg((3 << 11) | 20) & 0xFu; }
#define XB_SPIN(cond, bar) do { unsigned _sp = 0; while (cond) { __builtin_amdgcn_s_sleep(1); \
    if ((++_sp & 255u) == 0u) { if (xb_ld(&(bar)[XB_TMO])) break; if (_sp > XB_SPIN_CAP) { atomicAdd(&(bar)[XB_TMO], 1u); break; } } } } while (0)
struct XcdBarrier { unsigned* bar; unsigned x; volatile LAS unsigned* st; };
DEVFI XcdBarrier xcd_barrier_post(unsigned* bar, volatile LAS unsigned* st) {
    XcdBarrier b; b.bar = bar; b.x = xb_xcc_id(); b.st = st;
    if (threadIdx.x == 0) (void)xb_add(&bar[XB_XCNT(b.x)], 1u);
    return b;
}
DEVFI void xcd_barrier_complete(unsigned* bar, unsigned x, unsigned& nloc, unsigned& nx) {
    const unsigned G = gridDim.x * gridDim.y * gridDim.z;
    unsigned sum, cnt, mine, sp = 0u;
    for (;;) {
        sum = 0u; cnt = 0u; mine = 0u;
#pragma unroll
        for (unsigned j = 0; j < 16; ++j) { const unsigned c = xb_ld(&bar[XB_XCNT(j)]); sum += c; cnt += (c > 0u) ? 1u : 0u; mine = (j == x) ? c : mine; }
        if (sum == G) break;
        __builtin_amdgcn_s_sleep(1);
        if ((++sp & 255u) == 0u) { if (xb_ld(&bar[XB_TMO])) break; if (sp > XB_SPIN_CAP) { atomicAdd(&bar[XB_TMO], 1u); break; } }
    }
    nloc = mine > 0u ? mine : 1u; nx = cnt > 0u ? cnt : 1u;
}
DEVFI void xcd_barrier(const XcdBarrier& b) {
    asm volatile("s_waitcnt vmcnt(0)" ::: "memory");
    __syncthreads();
    if (threadIdx.x == 0) {
        unsigned* bar = b.bar;
        __builtin_amdgcn_s_waitcnt(0);
        unsigned nloc = b.st[0], nx = b.st[1];
        if (nloc == 0u) { xcd_barrier_complete(bar, b.x, nloc, nx); b.st[0] = nloc; b.st[1] = nx; }
        const unsigned old = xb_add(&bar[XB_XSUB(b.x)], 1u);
        const unsigned gen = old / nloc;
        if (old + 1u == (gen + 1u) * nloc) {
            __builtin_amdgcn_fence(__ATOMIC_RELEASE, "agent");
            asm volatile("s_waitcnt vmcnt(0)" ::: "memory");
            const unsigned og = xb_add(&bar[XB_TOP], 1u);
            const unsigned tg = og / nx;
            if (og + 1u == (tg + 1u) * nx) xb_add(&bar[XB_TOPGEN], 1u);
            else XB_SPIN(xb_ld(&bar[XB_TOPGEN]) == tg, bar);
            __builtin_amdgcn_fence(__ATOMIC_ACQUIRE, "agent");
            xb_add(&bar[XB_XGEN(b.x)], 1u);
            asm volatile("s_waitcnt vmcnt(0)" ::: "memory");
        } else {
            XB_SPIN(xb_ld(&bar[XB_XGEN(b.x)]) == gen, bar);
            __builtin_amdgcn_fence(__ATOMIC_ACQUIRE, "agent");
            asm volatile("s_waitcnt vmcnt(0)" ::: "memory");
        }
    }
    __syncthreads();
}

__global__ void __launch_bounds__(NTHR, 2) hymba_fwd(Params P) {
    extern __shared__ __attribute__((aligned(16))) unsigned char smem[];
    cg::grid_group grid = cg::this_grid();
    const int bid = blockIdx.x, nb = gridDim.x, tid = threadIdx.x;
    unsigned char* ws = P.ws;
    const int lo = P.ph_lo, hi = P.ph_hi;
#define IN_PH(k) (lo <= (k) && (k) < hi)
    volatile LAS unsigned* xb_st = (volatile LAS unsigned*)((LAS unsigned char*)smem + (LDS_BYTES - 32));
    if (tid == 0) { xb_st[0] = 0u; xb_st[1] = 0u; }
    __syncthreads();
    const XcdBarrier xbar = xcd_barrier_post((unsigned*)(ws + WS_CTL + 16384), xb_st);
#define SEAM(k) do { if (IN_PH(k) && IN_PH((k) + 1)) { if ((k) == 0) grid.sync(); else xcd_barrier(xbar); } } while (0)
    volatile unsigned* xq_slot = (volatile unsigned*)(smem + LDS_BYTES - 16);
    const unsigned xq_my = xb_xcc_id() & 7u;
#define XQ_FETCH(ctr_, dst_) do { if (tid == 0) *xq_slot = atomicAdd((ctr_), 1u); __syncthreads(); dst_ = *xq_slot; __syncthreads(); } while (0)

    if (IN_PH(0)) for (int rep_ = 0; rep_ < (PROBE_PHASE == 0 ? 2 : 1); ++rep_) { if (rep_) xcd_barrier(xbar); phase0(P, smem); }
    SEAM(0);
    if (IN_PH(1)) for (int rep_ = 0; rep_ < (PROBE_PHASE == 1 ? 2 : 1); ++rep_) {
        if (rep_) xcd_barrier(xbar);
#if DO_ATTN
        {
            unsigned* cbase = (unsigned*)(ws + WS_CTL) + 512 + rep_ * 128;
#pragma unroll 1
            for (unsigned att = 0; att < 8u; ++att) {
                const unsigned q = (xq_my + att) & 7u;
#pragma unroll 1
                for (;;) {
                    unsigned i; XQ_FETCH(cbase + q * 16, i);
                    if (i >= 768u) break;
                    const unsigned mtg = i / 192u, r = i % 192u, ntc = r >> 6, j = r & 63u;
                    const int mt = (int)(32u * q + mtg * 8u + (j & 7u)), nt = (int)(ntc * 8u + (j >> 3));
                    if (nt >= 23) continue;
                    EpiInProj epi; epi.m0 = mt * 256; epi.nt = nt; epi.ws = ws; epi.dt_bias = P.in[13]; epi.stage = smem;
                    gemm_tile3_i8<2, 4>(ws + WS_XN + (size_t)mt * 256 * 1024, 1024, ws + WS_WIN + (size_t)nt * 128 * 1024, 1024, (PROBE_PHASE == 1 && PROBE_VARIANT == 1 && rep_ == 0) ? 1 : 16,
                                        (const float*)(ws + WS_SXN) + mt * 256, (const float*)(ws + WS_SW) + nt * 128, smem, epi);
                    __syncthreads();
                }
            }
        }
#endif
    }
    SEAM(1);
    if (IN_PH(2)) for (int rep_ = 0; rep_ < (PROBE_PHASE == 2 ? 2 : 1); ++rep_) {
        if (rep_) xcd_barrier(xbar);
#if DO_ATTN && DO_NSA
        for (int item = bid; item < 256; item += nb) compress_item(P, item, smem);
#endif
#if DO_PEER
        if (rep_ == 0) { for (int row = bid * 4 + (tid >> 6); row < 2048; row += nb * 4) wq_quant_row(ws, row, tid & 63); }
#endif
#if DO_ATTN && DO_SSD
        {
            unsigned* cq = (unsigned*)(ws + WS_CTL) + 1792 + rep_ * 16;
#pragma unroll 1
            for (;;) {
                unsigned i; XQ_FETCH(cq, i);
                if (i >= 1024u) break;
                conv_item(P, (int)(2u * i));
                conv_item(P, (int)(2u * i + 1u));
            }
        }
#endif
    }
    SEAM(2);
    if (IN_PH(3)) for (int rep_ = 0; rep_ < ((PROBE_PHASE == 3 || PROBE_PHASE == 31 || PROBE_PHASE == 32) ? 2 : 1); ++rep_) {
        if (rep_) xcd_barrier(xbar);
#if DO_ATTN
        unsigned* ctr0 = (unsigned*)(ws + WS_CTL) + rep_ * 8 * 16;
        volatile unsigned* s_item = (volatile unsigned*)(smem + LDS_BYTES - 16);
        const unsigned myq = xb_xcc_id() & 7u;
        const unsigned lim_lo = (rep_ == 1 && PROBE_PHASE == 32) ? 16u : 0u;
        const unsigned lim_hi = (rep_ == 1 && PROBE_PHASE == 31) ? 16u : 272u;
#define FETCH_ITEM(dst) do { if (tid == 0) *s_item = atomicAdd(ctr, 1u); __syncthreads(); dst = *s_item + lim_lo; __syncthreads(); } while (0)
#pragma unroll 1
        for (unsigned att = 0; att < 8u; ++att) {
            const unsigned q = (myq + att) & 7u;
            unsigned* ctr = ctr0 + q * 16;
            unsigned item;
            FETCH_ITEM(item);
#pragma unroll 1
            while (item < 16u) {
                const unsigned sid = q * 16u + item;
#if DO_SSD
                ssd_item(P, sid >> 3, sid & 7, smem);
#else
                {
                    const int b = sid >> 3, hd = sid & 7;
                    for (int i = tid; i < 4096 * 8; i += NTHR) {
                        const size_t tk = (size_t)b * 4096 + (i >> 3);
                        *(u32x4*)((bf16_t*)(ws + WS_AMAT) + tk * 1024 + 512 + hd * 64 + (i & 7) * 8) = (u32x4){0u, 0u, 0u, 0u};
                        if ((i & 7) < 2) ((float*)(ws + WS_SSS))[tk * 16 + hd * 2 + (i & 7)] = 0.f;
                    }
                }
#endif
                FETCH_ITEM(item);
            }
#pragma unroll 1
            while (item < lim_hi) {
                const int j = (int)item - 16;
                const int qb = 63 - (j & 63), bg = (int)q + 8 * (j >> 6);
#if DO_NSA
                nsa_item(P, bg, qb, smem, (rep_ == 1 && PROBE_PHASE == 32) ? PROBE_VARIANT : 0);
#else
                {
                    const int b = bg >> 1, g = bg & 1;
                    for (int i = tid; i < 64 * 32; i += NTHR) {
                        const size_t tk = (size_t)b * 4096 + qb * 64 + (i >> 5);
                        *(u32x4*)((bf16_t*)(ws + WS_AMAT) + tk * 1024 + g * 256 + (i & 31) * 8) = (u32x4){0u, 0u, 0u, 0u};
                        if ((i & 31) < 4) ((float*)(ws + WS_SSN))[tk * 8 + g * 4 + (i & 31)] = 0.f;
                    }
                }
#endif
                FETCH_ITEM(item);
            }
        }
#undef FETCH_ITEM
#endif
    }
    SEAM(3);
    if (IN_PH(4)) for (int rep_ = 0; rep_ < (PROBE_PHASE == 4 ? 2 : 1); ++rep_) {
        if (rep_) xcd_barrier(xbar);
#if DO_ATTN
        {
            unsigned* cbase = (unsigned*)(ws + WS_CTL) + 768 + rep_ * 128;
#pragma unroll 1
            for (unsigned att = 0; att < 8u; ++att) {
                const unsigned q = (xq_my + att) & 7u;
#pragma unroll 1
                for (;;) {
                    unsigned i; XQ_FETCH(cbase + q * 16, i);
                    if (i >= 256u) break;
                    const int mt = (int)(32u * q + (i >> 6) * 8u + (i & 7u)), nt = (int)((i >> 3) & 7u);
                    EpiOutProj<4> epi; epi.m0 = mt * 256; epi.n0 = nt * 128; epi.x = P.in[0]; epi.x1 = P.out; epi.xq8 = ws + WS_XN; epi.xsc = (const float*)(ws + WS_SXR);
                    epi.x1b = (bf16_t*)(ws + WS_X1B); epi.ssx = (float*)(ws + WS_SSX); epi.stage = smem; epi.x8 = ws + WS_X8; epi.sx = (float*)(ws + WS_SX);
                    epi.init(ws, (tid >> 6) >> 1, tid & 63);
                    gemm_tile3<2, 4, true>((const bf16_t*)(ws + WS_AMAT) + (size_t)mt * 256 * 1024, 1024,
                                           (const bf16_t*)(ws + WS_WOUT) + (size_t)nt * 128 * 1024, 1024, (PROBE_PHASE == 4 && PROBE_VARIANT == 1 && rep_ == 0) ? 1 : 16, smem, epi);
                    __syncthreads();
                }
            }
        }
#else
        copy_x1(P);
#endif
    }
#if DO_PEER && DO_ATTN
    if (IN_PH(4)) {
        xcd_barrier(xbar);
        size_t zoff_ = 0; asm volatile("" : "+s"(zoff_)); unsigned char* wsl = P.ws + zoff_;
        const int lane = tid & 63, w = tid >> 6;
        for (size_t tok = ((size_t)bid * 4 + w) * 4; tok < (size_t)T; tok += (size_t)nb * 16) x1_requant_tokens4(wsl, tok, lane);
    }
#endif
    SEAM(4);
    if (IN_PH(5)) for (int rep_ = 0; rep_ < (PROBE_PHASE == 5 ? 2 : 1); ++rep_) {
        if (rep_) xcd_barrier(xbar);
#if DO_PEER
        {
            unsigned* cbase = (unsigned*)(ws + WS_CTL) + 1024 + rep_ * 128;
#pragma unroll 1
            for (unsigned att = 0; att < 8u; ++att) {
                const unsigned q = (xq_my + att) & 7u;
#pragma unroll 1
                for (;;) {
                    unsigned i; XQ_FETCH(cbase + q * 16, i);
                    if (i >= 512u) break;
                    const unsigned g6 = i >> 6, j = i & 63u;
                    const int mt = (int)(64u * q + (g6 >> 1) * 16u + (j & 15u)), hh = (int)((g6 & 1u) * 4u + (j >> 4));
                    peer_route_item(P, (PROBE_PHASE == 5 && PROBE_VARIANT == 2 && rep_ == 0) ? 0 : mt * 8 + hh, smem, (int)(((j >> 4) * 4u + (j & 15u)) & 15u), (PROBE_PHASE == 5 && PROBE_VARIANT == 1 && rep_ == 0) ? 1 : 16);
                    __syncthreads();
                }
            }
        }
#endif
    }
    SEAM(5);
    if (IN_PH(6)) for (int rep_ = 0; rep_ < (PROBE_PHASE == 6 ? 2 : 1); ++rep_) {
        if (rep_) xcd_barrier(xbar);
#if DO_PEER
        size_t zoff_ = 0; asm volatile("" : "+s"(zoff_)); unsigned char* wsl = P.ws + zoff_;
        unsigned* cbase = (unsigned*)(wsl + WS_CTL) + 1280 + rep_ * 128;
        const int lane = tid & 63, w = tid >> 6;
#pragma unroll 1
        for (unsigned att = 0; att < 8u; ++att) {
            const unsigned q = (xq_my + att) & 7u;
#pragma unroll 1
            for (;;) {
                unsigned i; XQ_FETCH(cbase + q * 16, i);
                if (i >= 512u) break;
                const size_t t0 = (size_t)(q >> 2) * 32768 + (size_t)i * 64 + w * 16;
                peer_u_task(wsl, t0, (int)q, lane, (int*)smem + w * 2048);
                peer_u_task(wsl, t0 + 8, (int)q, lane, (int*)smem + w * 2048);
            }
        }
#endif
    }
    SEAM(6);
    if (IN_PH(7)) {
#if DO_PEER
        size_t zoff_ = 0; asm volatile("" : "+s"(zoff_)); unsigned char* wsl = P.ws + zoff_;
        const int lane = tid & 63, w = tid >> 6;
        for (size_t tok = ((size_t)bid * 4 + w) * 4; tok < (size_t)T; tok += (size_t)nb * 16) peer_c_tokens4(wsl, tok, lane);
#endif
    }
    SEAM(7);
    if (IN_PH(8)) for (int rep_ = 0; rep_ < (PROBE_PHASE == 8 ? 2 : 1); ++rep_) {
        if (rep_) xcd_barrier(xbar);
#if DO_PEER
        size_t zoff_ = 0; asm volatile("" : "+s"(zoff_)); unsigned char* wsl = P.ws + zoff_;
        unsigned* cbase = (unsigned*)(wsl + WS_CTL) + 1536 + rep_ * 128;
        const bool dry = (PROBE_PHASE == 8) && rep_ == 0;
        const int lane = tid & 63, w = tid >> 6;
#pragma unroll 1
        for (unsigned att = 0; att < 8u; ++att) {
            const unsigned q = (xq_my + att) & 7u;
#pragma unroll 1
            for (;;) {
                unsigned i; XQ_FETCH(cbase + q * 16, i);
                if (i >= 512u) break;
                const size_t t0 = (size_t)(q >> 2) * 32768 + (size_t)i * 64 + w * 16;
                peer_v_task(P, wsl, t0, (int)q, lane, dry, (int*)smem + w * 2048);
                peer_v_task(P, wsl, t0 + 8, (int)q, lane, dry, (int*)smem + w * 2048);
            }
        }
#endif
    }
    SEAM(8);
    if (IN_PH(9)) {
        const int lane = tid & 63, w = tid >> 6;
        for (size_t tok = ((size_t)bid * 4 + w) * 4; tok < (size_t)T; tok += (size_t)nb * 16) final_norm_tokens4(P, tok, lane);
    }
}

extern "C" void kernel_launch(void* const* d_in, const int* in_sizes, int n_in, void* d_out, int out_size, void* d_ws, size_t ws_size,
                              hipStream_t stream) {
    static int grid_blocks = 0;
    if (grid_blocks == 0) {
        if (n_in != 25 || out_size != T * D || ws_size < WS_END) {
            fprintf(stderr, "kernel_launch: unexpected shapes (n_in %d, out %d, ws %zu < %zu)\n", n_in, out_size, ws_size, (size_t)WS_END);
            grid_blocks = -1;
            return;
        }
        int dev = 0, cus = 0, per_cu = 0;
        hipGetDevice(&dev);
        hipDeviceGetAttribute(&cus, hipDeviceAttributeMultiprocessorCount, dev);
        hipFuncSetAttribute((const void*)hymba_fwd, hipFuncAttributeMaxDynamicSharedMemorySize, LDS_BYTES);
        hipOccupancyMaxActiveBlocksPerMultiprocessor(&per_cu, (const void*)hymba_fwd, NTHR, LDS_BYTES);
        if (per_cu < 1) per_cu = 1;
        if (per_cu > 2) per_cu = 2;
        grid_blocks = cus * per_cu;
        fprintf(stderr, "kernel_launch: %d CUs x %d blocks\n", cus, per_cu);
    }
    if (grid_blocks < 0) return;
    (void)hipMemsetAsync((char*)d_ws + WS_CTL, 0, 32768, stream);
    Params p{};
    for (int i = 0; i < 25; ++i) p.in[i] = (const float*)d_in[i];
    p.out = (float*)d_out;
    p.ws = (unsigned char*)d_ws;
#if N_LAUNCH_SPLIT
    for (int ph = 0; ph < 10; ++ph) {
        p.ph_lo = ph; p.ph_hi = ph + 1;
        void* args[] = {&p};
        hipLaunchCooperativeKernel((void*)hymba_fwd, dim3(grid_blocks), dim3(NTHR), args, LDS_BYTES, stream);
    }
#else
    p.ph_lo = 0; p.ph_hi = 10;
    void* args[] = {&p};
    hipError_t e = hipLaunchCooperativeKernel((void*)hymba_fwd, dim3(grid_blocks), dim3(NTHR), args, LDS_BYTES, stream);
    if (e != hipSuccess) fprintf(stderr, "cooperative launch failed: %s (grid %d)\n", hipGetErrorString(e), grid_blocks);
#endif
}
```

```cpp
#include <hip/hip_runtime.h>
#include <utility>
#include <hip/hip_cooperative_groups.h>
#include <cstdio>
#include <cstdint>
namespace cg = cooperative_groups;

#ifndef DO_ATTN
#define DO_ATTN 1
#endif
#ifndef DO_NSA
#define DO_NSA 1
#endif
#ifndef DO_SSD
#define DO_SSD 1
#endif
#ifndef DO_PEER
#define DO_PEER 1
#endif
#ifndef PROBE_PHASE
#define PROBE_PHASE -1
#endif
#ifndef PROBE_VARIANT
#define PROBE_VARIANT 0
#endif
#define KROT_MASK(nk_) ((nk_) - 1)
#ifndef N_LAUNCH_SPLIT
#define N_LAUNCH_SPLIT 0
#endif

#define DEVFI __device__ __forceinline__

typedef unsigned short bf16_t;
typedef short bf16x8 __attribute__((ext_vector_type(8)));
typedef float f32x16 __attribute__((ext_vector_type(16)));
typedef float f32x4 __attribute__((ext_vector_type(4)));
typedef float f32x2 __attribute__((ext_vector_type(2)));
typedef unsigned u32x4 __attribute__((ext_vector_type(4)));
typedef unsigned u32x2 __attribute__((ext_vector_type(2)));

constexpr int NTHR = 256;
constexpr int T = 65536, S = 4096, D = 1024;
constexpr int NPROJ_SRC = 2848, NPROJ = 2944;
constexpr float EPS = 1e-6f;
constexpr int LDS_BYTES = 80896;

constexpr size_t MiB = 1u << 20;
constexpr size_t WS_CTL = 0;
constexpr size_t WS_WIN = 1 * MiB;
constexpr size_t WS_WOUT = 7 * MiB;
constexpr size_t WS_WQ = 9 * MiB;
constexpr size_t WS_W1K = 13 * MiB;
constexpr size_t WS_W1V = 14 * MiB;
constexpr size_t WS_W2K = 15 * MiB;
constexpr size_t WS_W2V = 15 * MiB + 65536;
constexpr size_t WS_BIASK = 15 * MiB + 131072;
constexpr size_t WS_BIASV = 15 * MiB + 135168;
constexpr size_t WS_ROPE = 15 * MiB + 262144;
constexpr size_t WS_KEYS = 16 * MiB;
constexpr size_t WS_KCP = 17 * MiB;
constexpr size_t WS_SSN = 25 * MiB;
constexpr size_t WS_SSS = 27 * MiB;
constexpr size_t WS_SSX = 31 * MiB;
constexpr size_t WS_GATES = 35 * MiB;
constexpr size_t WS_DT = 41 * MiB;
constexpr size_t WS_U = 48 * MiB;
constexpr size_t WS_V = 64 * MiB;
constexpr size_t WS_SU = 80 * MiB;
constexpr size_t WS_SV = 80 * MiB + 65536;
constexpr size_t WS_XN = 112 * MiB;
constexpr size_t WS_Q = 240 * MiB;
constexpr size_t WS_KC = 304 * MiB;
constexpr size_t WS_VC = 320 * MiB;
constexpr size_t WS_KS = 336 * MiB;
constexpr size_t WS_VST = 352 * MiB;
constexpr size_t WS_KW = 368 * MiB;
constexpr size_t WS_VWT = 384 * MiB;
constexpr size_t WS_Z = 400 * MiB;
constexpr size_t WS_XBC = 464 * MiB;
constexpr size_t WS_AMAT = 592 * MiB;
constexpr size_t WS_X1B = 720 * MiB;
constexpr size_t WS_QP = 112 * MiB;
constexpr size_t WS_IDX = 400 * MiB;
constexpr size_t WS_GATE = 432 * MiB;
constexpr size_t WS_XBC2 = 848 * MiB;
constexpr size_t WS_X8 = WS_Q;
constexpr size_t WS_SX = WS_GATES;
constexpr size_t WS_SXN = WS_CTL + 512 * 1024;
constexpr size_t WS_SXR = WS_CTL + 256 * 1024;
constexpr size_t WS_SW = WS_CTL + 768 * 1024;
constexpr size_t WS_WQ8 = 20 * MiB;
constexpr size_t WS_SWQ = 22 * MiB;
constexpr size_t WS_X8T = WS_KC;
constexpr size_t WS_QF = WS_KW;
constexpr size_t WS_END = 976 * MiB;

struct Params {
    const float* in[25];
    float* out;
    unsigned char* ws;
    int ph_lo, ph_hi;
};

DEVFI unsigned pk_bf16(float lo, float hi) { unsigned r; asm("v_cvt_pk_bf16_f32 %0, %1, %2" : "=v"(r) : "v"(lo), "v"(hi)); return r; }
DEVFI float bf_lo(unsigned u) { return __uint_as_float(u << 16); }
DEVFI float bf_hi(unsigned u) { return __uint_as_float(u & 0xffff0000u); }
DEVFI float bf2f(bf16_t v) { return __uint_as_float(((unsigned)v) << 16); }
DEVFI bf16_t f2bf(float f) { return (bf16_t)(pk_bf16(f, 0.f) & 0xffffu); }
template <int CTRL> DEVFI float dpp_f(float v) { return __int_as_float(__builtin_amdgcn_update_dpp(0, __float_as_int(v), CTRL, 0xF, 0xF, true)); }
template <int CTRL> DEVFI unsigned dpp_u(unsigned v) { return (unsigned)__builtin_amdgcn_update_dpp(0, (int)v, CTRL, 0xF, 0xF, true); }
DEVFI float row16_sum(float v) { v += dpp_f<0x128>(v); v += dpp_f<0x124>(v); v += dpp_f<0x122>(v); v += dpp_f<0x121>(v); return v; }
DEVFI float row16_max(float v) { v = fmaxf(v, dpp_f<0x128>(v)); v = fmaxf(v, dpp_f<0x124>(v)); v = fmaxf(v, dpp_f<0x122>(v)); v = fmaxf(v, dpp_f<0x121>(v)); return v; }
DEVFI float xor1f(float v) { return dpp_f<0xB1>(v); }
DEVFI float xor2f(float v) { return dpp_f<0x4E>(v); }
DEVFI float xor4f(float v) { return dpp_f<0x141>(dpp_f<0x1B>(v)); }
DEVFI float xor32f(float x) {
#if __has_builtin(__builtin_amdgcn_permlane32_swap)
    const unsigned u = __float_as_uint(x);
    const auto pr = __builtin_amdgcn_permlane32_swap(u, u, false, false);
    return __uint_as_float((threadIdx.x & 32) ? pr[0] : pr[1]);
#else
    return __shfl_xor(x, 32);
#endif
}
DEVFI float xor16f(float x) {
#if __has_builtin(__builtin_amdgcn_permlane16_swap)
    const unsigned u = __float_as_uint(x);
    const auto pr = __builtin_amdgcn_permlane16_swap(u, u, false, false);
    return __uint_as_float((threadIdx.x & 16) ? pr[0] : pr[1]);
#else
    return __shfl_xor(x, 16);
#endif
}
DEVFI float wave_sum(float v) { v = row16_sum(v); v += xor16f(v); v += xor32f(v); return v; }
DEVFI float wave_max(float v) { v = row16_max(v); v = fmaxf(v, xor16f(v)); v = fmaxf(v, xor32f(v)); return v; }
DEVFI float gelu_tanh(float x) {
    const float u = 0.7978845608028654f * (x + 0.044715f * x * x * x);
    const float e = __expf(2.f * u);
    const float t = 1.f - 2.f * __builtin_amdgcn_rcpf(e + 1.f);
    return 0.5f * x * (1.f + t);
}
DEVFI float sigmoidf_(float x) { return __builtin_amdgcn_rcpf(1.f + __expf(-x)); }
DEVFI float siluf_(float x) { return x * __builtin_amdgcn_rcpf(1.f + __expf(-x)); }
DEVFI float softplusf_(float x) { return x > 20.f ? x : log1pf(__expf(x)); }
DEVFI unsigned xb_xcc_id();
DEVFI f32x16 mfma32(bf16x8 a, bf16x8 b, f32x16 c) { return __builtin_amdgcn_mfma_f32_32x32x16_bf16(a, b, c, 0, 0, 0); }
DEVFI f32x16 zero16() { f32x16 z;
#pragma unroll
    for (int i = 0; i < 16; ++i) z[i] = 0.f;
    return z; }
DEVFI int perm16(int o) { return (o & 3) | ((o & 4) << 1) | ((o & 8) >> 1); }

#define LAS3 __attribute__((address_space(3)))
template <int FT, int TT, int WNS, bool HOOK, class Epi>
DEVFI void gemm_tile(const bf16_t* __restrict__ A, size_t lda, const bf16_t* __restrict__ Bt, size_t ldb, int nk,
                     unsigned char* smem, Epi& epi, const int rot = 0) {
    int tid = threadIdx.x; asm volatile("" : "+v"(tid));
    const int lane = tid & 63, wid = __builtin_amdgcn_readfirstlane(tid >> 6);
    const int wm = (WNS == 2) ? (wid >> 1) : wid, wn = (WNS == 2) ? (wid & 1) : 0;
    constexpr int AROWS = (4 / WNS) * 32 * TT, BROWS = WNS * FT * 32;
    constexpr int ABYTES = AROWS * 128, BBYTES = BROWS * 128, BUFBYTES = ABYTES + BBYTES;
    LAS3 unsigned char* lds = (LAS3 unsigned char*)smem;
    const int grow = lane >> 3, gch = (lane & 7) ^ grow;
    const unsigned aoff = (unsigned)(((wid * 8 + grow) * (int)lda + gch * 8) * 2);
    const unsigned boff = (unsigned)(((wid * 8 + grow) * (int)ldb + gch * 8) * 2);
    f32x16 acc[FT][TT];
#pragma unroll
    for (int ft = 0; ft < FT; ++ft)
#pragma unroll
        for (int tt = 0; tt < TT; ++tt) acc[ft][tt] = zero16();
#define GEMM_ISSUE(kt_, buf_) do { \
        _Pragma("unroll") for (int i_ = 0; i_ < AROWS / 32; ++i_) \
            __builtin_amdgcn_global_load_lds((const unsigned*)((const char*)(A + (size_t)(i_ * 32) * lda + (((kt_) + rot) & KROT_MASK(nk)) * 64) + aoff), \
                                             (LAS3 unsigned*)(lds + (buf_) * BUFBYTES + (i_ * 4 + wid) * 1024), 16, 0, 0); \
        _Pragma("unroll") for (int i_ = 0; i_ < BROWS / 32; ++i_) \
            __builtin_amdgcn_global_load_lds((const unsigned*)((const char*)(Bt + (size_t)(i_ * 32) * ldb + (((kt_) + rot) & KROT_MASK(nk)) * 64) + boff), \
                                             (LAS3 unsigned*)(lds + (buf_) * BUFBYTES + ABYTES + (i_ * 4 + wid) * 1024), 16, 0, 0); \
    } while (0)
    GEMM_ISSUE(0, 0);
    asm volatile("s_waitcnt vmcnt(0)" ::: "memory");
    __syncthreads();
    const int frow = lane & 31, h5 = lane >> 5;
    for (int kt = 0; kt < nk; ++kt) {
        const int buf = kt & 1;
        if (kt + 1 < nk) GEMM_ISSUE(kt + 1, buf ^ 1);
        const unsigned char* as = smem + buf * BUFBYTES;
        const unsigned char* bs = as + ABYTES;
#pragma unroll
        for (int ks = 0; ks < 4; ++ks) {
            bf16x8 fa[FT], fb[TT];
#pragma unroll
            for (int ft = 0; ft < FT; ++ft) { const int rr = wn * FT * 32 + ft * 32 + frow; fa[ft] = *(const bf16x8*)(bs + rr * 128 + (((ks * 2 + h5) ^ (rr & 7)) << 4)); }
#pragma unroll
            for (int tt = 0; tt < TT; ++tt) { const int rr = wm * 32 * TT + tt * 32 + frow; fb[tt] = *(const bf16x8*)(as + rr * 128 + (((ks * 2 + h5) ^ (rr & 7)) << 4)); }
#pragma unroll
            for (int ft = 0; ft < FT; ++ft)
#pragma unroll
                for (int tt = 0; tt < TT; ++tt) acc[ft][tt] = mfma32(fa[ft], fb[tt], acc[ft][tt]);
        }
        if (HOOK) epi.hook(kt, acc);
        asm volatile("s_waitcnt vmcnt(0)" ::: "memory");
        __syncthreads();
    }
#undef GEMM_ISSUE
    epi(acc, wm, wn, lane);
}

template <int FT, int TT, bool HOOK, class Epi, int WNS = 2>
DEVFI void gemm_tile3(const bf16_t* __restrict__ A, size_t lda, const bf16_t* __restrict__ Bt, size_t ldb, int nk64,
                      unsigned char* smem, Epi& epi) {
    int tid = threadIdx.x; asm volatile("" : "+v"(tid));
    const int lane = tid & 63, wid = __builtin_amdgcn_readfirstlane(tid >> 6);
    const int wm = (WNS == 2) ? (wid >> 1) : wid, wn = (WNS == 2) ? (wid & 1) : 0;
    constexpr int AROWS = (4 / WNS) * 32 * TT, BROWS = WNS * FT * 32;
    constexpr int ABYTES = AROWS * 64, BBYTES = BROWS * 64, STBYTES = ABYTES + BBYTES;
    constexpr int NA = AROWS / 64, NB = BROWS / 64;
    static_assert(NA + NB == 6, "the counted wait below assumes 6 loads per wave per stage");
    static_assert(3 * STBYTES <= 73728, "ring must fit the LDS budget");
    LAS3 unsigned char* lds = (LAS3 unsigned char*)smem;
    const int nk = nk64 * 2;
    const int grow = lane >> 2, gch = (lane & 3) ^ ((grow >> 2) & 3);
    const unsigned aoff = (unsigned)(((wid * 16 + grow) * (int)lda + gch * 8) * 2);
    const unsigned boff = (unsigned)(((wid * 16 + grow) * (int)ldb + gch * 8) * 2);
    f32x16 acc[FT][TT];
#pragma unroll
    for (int ft = 0; ft < FT; ++ft)
#pragma unroll
        for (int tt = 0; tt < TT; ++tt) acc[ft][tt] = zero16();
#define GEMM3_ISSUE(kt_) do { const int st_ = (kt_) % 3; \
        _Pragma("unroll") for (int i_ = 0; i_ < NA; ++i_) \
            __builtin_amdgcn_global_load_lds((const unsigned*)((const char*)(A + (size_t)(i_ * 64) * lda + (kt_) * 32) + aoff), \
                                             (LAS3 unsigned*)(lds + st_ * STBYTES + (i_ * 4 + wid) * 1024), 16, 0, 0); \
        _Pragma("unroll") for (int i_ = 0; i_ < NB; ++i_) \
            __builtin_amdgcn_global_load_lds((const unsigned*)((const char*)(Bt + (size_t)(i_ * 64) * ldb + (kt_) * 32) + boff), \
                                             (LAS3 unsigned*)(lds + st_ * STBYTES + ABYTES + (i_ * 4 + wid) * 1024), 16, 0, 0); \
    } while (0)
    GEMM3_ISSUE(0);
    GEMM3_ISSUE(1);
    const int frow = lane & 31, h5 = lane >> 5;
    int st = 0;
    for (int kt = 0; kt < nk; ++kt) {
        if (kt + 1 < nk) asm volatile("s_waitcnt vmcnt(6)" ::: "memory"); else asm volatile("s_waitcnt vmcnt(0)" ::: "memory");
        asm volatile("s_waitcnt lgkmcnt(0)" ::: "memory");
        __builtin_amdgcn_s_barrier();
        asm volatile("" ::: "memory");
        if (kt + 2 < nk) GEMM3_ISSUE(kt + 2);
        const unsigned char* as = smem + st * STBYTES;
        const unsigned char* bs = as + ABYTES;
        st = (st == 2) ? 0 : st + 1;
#pragma unroll
        for (int ks = 0; ks < 2; ++ks) {
            bf16x8 fa[FT], fb[TT];
#pragma unroll
            for (int ft = 0; ft < FT; ++ft) { const int rr = wn * FT * 32 + ft * 32 + frow; fa[ft] = *(const bf16x8*)(bs + rr * 64 + (((ks * 2 + h5) ^ ((rr >> 2) & 3)) << 4)); }
#pragma unroll
            for (int tt = 0; tt < TT; ++tt) { const int rr = wm * 32 * TT + tt * 32 + frow; fb[tt] = *(const bf16x8*)(as + rr * 64 + (((ks * 2 + h5) ^ ((rr >> 2) & 3)) << 4)); }
#pragma unroll
            for (int ft = 0; ft < FT; ++ft)
#pragma unroll
                for (int tt = 0; tt < TT; ++tt) acc[ft][tt] = mfma32(fa[ft], fb[tt], acc[ft][tt]);
        }
        if (HOOK) { if (kt & 1) epi.hook(kt >> 1, acc); }
    }
#undef GEMM3_ISSUE
    asm volatile("s_waitcnt lgkmcnt(0)" ::: "memory");
    __builtin_amdgcn_s_barrier();
    asm volatile("" ::: "memory");
    epi(acc, wm, wn, lane);
}

typedef int i32x4v __attribute__((ext_vector_type(4)));
typedef int i32x16v __attribute__((ext_vector_type(16)));
template <int FT, int TT, class Epi>
DEVFI void gemm_tile3_i8(const unsigned char* __restrict__ A, size_t lda, const unsigned char* __restrict__ Bt, size_t ldb, int nk,
                         const float* __restrict__ rowscale, const float* __restrict__ colscale, unsigned char* smem, Epi& epi, const int rot = 0) {
    int tid = threadIdx.x; asm volatile("" : "+v"(tid));
    const int lane = tid & 63, wid = __builtin_amdgcn_readfirstlane(tid >> 6);
    const int wm = wid >> 1, wn = wid & 1;
    constexpr int AROWS = 2 * 32 * TT, BROWS = 2 * FT * 32;
    constexpr int ABYTES = AROWS * 64, BBYTES = BROWS * 64, STBYTES = ABYTES + BBYTES;
    constexpr int NA = AROWS / 64, NB = BROWS / 64;
    static_assert(NA + NB == 6, "the counted wait below assumes 6 loads per wave per stage");
    LAS3 unsigned char* lds = (LAS3 unsigned char*)smem;
    const int grow = lane >> 2, gch = (lane & 3) ^ ((grow >> 2) & 3);
    const unsigned aoff = (unsigned)((wid * 16 + grow) * (int)lda + gch * 16);
    const unsigned boff = (unsigned)((wid * 16 + grow) * (int)ldb + gch * 16);
    i32x16v acc[FT][TT];
#pragma unroll
    for (int ft = 0; ft < FT; ++ft)
#pragma unroll
        for (int tt = 0; tt < TT; ++tt)
#pragma unroll
            for (int i = 0; i < 16; ++i) acc[ft][tt][i] = 0;
#define GEMM3I_ISSUE(kt_) do { const int st_ = (kt_) % 3; \
        _Pragma("unroll") for (int i_ = 0; i_ < NA; ++i_) \
            __builtin_amdgcn_global_load_lds((const unsigned*)(A + (size_t)(i_ * 64) * lda + (((kt_) + rot) & KROT_MASK(nk)) * 64 + aoff), \
                                             (LAS3 unsigned*)(lds + st_ * STBYTES + (i_ * 4 + wid) * 1024), 16, 0, 0); \
        _Pragma("unroll") for (int i_ = 0; i_ < NB; ++i_) \
            __builtin_amdgcn_global_load_lds((const unsigned*)(Bt + (size_t)(i_ * 64) * ldb + (((kt_) + rot) & KROT_MASK(nk)) * 64 + boff), \
                                             (LAS3 unsigned*)(lds + st_ * STBYTES + ABYTES + (i_ * 4 + wid) * 1024), 16, 0, 0); \
    } while (0)
    GEMM3I_ISSUE(0);
    GEMM3I_ISSUE(1);
    const int frow = lane & 31, h5 = lane >> 5;
    int st = 0;
    for (int kt = 0; kt < nk; ++kt) {
        if (kt + 1 < nk) asm volatile("s_waitcnt vmcnt(6)" ::: "memory"); else asm volatile("s_waitcnt vmcnt(0)" ::: "memory");
        asm volatile("s_waitcnt lgkmcnt(0)" ::: "memory");
        __builtin_amdgcn_s_barrier();
        asm volatile("" ::: "memory");
        if (kt + 2 < nk) GEMM3I_ISSUE(kt + 2);
        const unsigned char* as = smem + st * STBYTES;
        const unsigned char* bs = as + ABYTES;
        st = (st == 2) ? 0 : st + 1;
#pragma unroll
        for (int ks = 0; ks < 2; ++ks) {
            i32x4v fa[FT], fb[TT];
#pragma unroll
            for (int ft = 0; ft < FT; ++ft) { const int rr = wn * FT * 32 + ft * 32 + frow; fa[ft] = *(const i32x4v*)(bs + rr * 64 + (((ks * 2 + h5) ^ ((rr >> 2) & 3)) << 4)); }
#pragma unroll
            for (int tt = 0; tt < TT; ++tt) { const int rr = wm * 32 * TT + tt * 32 + frow; fb[tt] = *(const i32x4v*)(as + rr * 64 + (((ks * 2 + h5) ^ ((rr >> 2) & 3)) << 4)); }
#pragma unroll
            for (int ft = 0; ft < FT; ++ft)
#pragma unroll
                for (int tt = 0; tt < TT; ++tt) acc[ft][tt] = __builtin_amdgcn_mfma_i32_32x32x32_i8(fa[ft], fb[tt], acc[ft][tt], 0, 0, 0);
        }
    }
#undef GEMM3I_ISSUE
    asm volatile("s_waitcnt lgkmcnt(0)" ::: "memory");
    __builtin_amdgcn_s_barrier();
    asm volatile("" ::: "memory");
    f32x16 accf[FT][TT];
#pragma unroll
    for (int tt = 0; tt < TT; ++tt) {
        const float rsc = rowscale[wm * 32 * TT + tt * 32 + frow];
#pragma unroll
        for (int ft = 0; ft < FT; ++ft)
#pragma unroll
            for (int gq = 0; gq < 4; ++gq) {
                const f32x4 cs = *(const f32x4*)(colscale + wn * FT * 32 + ft * 32 + 8 * gq + 4 * h5);
#pragma unroll
                for (int e = 0; e < 4; ++e) accf[ft][tt][4 * gq + e] = (float)acc[ft][tt][4 * gq + e] * (rsc * cs[e]);
            }
    }
    epi(accf, wm, wn, lane);
}

DEVFI int inproj_colmap(int n) {
    if (n < 1280) return n;
    if (n < 2816) return n + 24;
    if (n < 2840) return n - 1536;
    if (n < 2848) return n;
    return -1;
}
DEVFI void transpose_unit(const float* __restrict__ W, int K, int N, bf16_t* __restrict__ dst, int k0, int n0, bool inproj,
                          const float* __restrict__ g0, const float* __restrict__ g1, int gsplit, float* tile) {
    const int tid = threadIdx.x;
    const int n = tid & 63;
    int col = n0 + n;
    if (inproj) col = inproj_colmap(col);
#pragma unroll 4
    for (int i = 0; i < 16; ++i) {
        const int k = i * 4 + (tid >> 6);
        const int kk = k0 + k;
        float v = 0.f;
        if (col >= 0) {
            v = W[(size_t)kk * N + col];
            if (g0) v *= (kk < gsplit ? g0[kk] : g1[kk - gsplit]);
        }
        tile[k * 65 + n] = v;
    }
    __syncthreads();
    const int nn = tid >> 2, kq = tid & 3;
    unsigned o[8];
#pragma unroll
    for (int j = 0; j < 8; ++j) o[j] = pk_bf16(tile[(kq * 16 + 2 * j) * 65 + nn], tile[(kq * 16 + 2 * j + 1) * 65 + nn]);
    u32x4* d = (u32x4*)(dst + (size_t)(n0 + nn) * K + k0 + kq * 16);
    d[0] = (u32x4){o[0], o[1], o[2], o[3]};
    d[1] = (u32x4){o[4], o[5], o[6], o[7]};
    __syncthreads();
}

DEVFI void phase0(const Params& P_, unsigned char* smem) {
    size_t zoff_ = 0; asm volatile("" : "+s"(zoff_)); const Params& P = *(const Params*)((const char*)&P_ + zoff_);
    const int bid = blockIdx.x, nb = gridDim.x, tid = threadIdx.x, lane = tid & 63, w = tid >> 6;
    unsigned char* ws = P.ws;
    float* tile = (float*)smem;
    for (int u = bid; u < 46 * 8; u += nb) {
        const float* W = P.in[2]; const float* gn = P.in[1];
        const int cg = u >> 3, kb = u & 7, n0 = cg * 64;
        const int c4 = (tid & 15) * 4, rr = tid >> 4;
        const int col = inproj_colmap(n0 + c4);
        float* red = tile;
        float* qs = tile + 1024;
        unsigned char* t8 = (unsigned char*)(tile + 1088);
        f32x4 am4 = (f32x4){0.f, 0.f, 0.f, 0.f};
        if (col >= 0) {
#pragma unroll 1
            for (int k0 = 0; k0 < 1024; k0 += 128) {
                f32x4 v[8]; float g[8];
#pragma unroll
                for (int i = 0; i < 8; ++i) { v[i] = *(const f32x4*)(W + (size_t)(k0 + i * 16 + rr) * NPROJ_SRC + col); g[i] = fabsf(gn[k0 + i * 16 + rr]); }
#pragma unroll
                for (int i = 0; i < 8; ++i) {
                    am4.x = fmaxf(am4.x, fabsf(v[i].x) * g[i]); am4.y = fmaxf(am4.y, fabsf(v[i].y) * g[i]);
                    am4.z = fmaxf(am4.z, fabsf(v[i].z) * g[i]); am4.w = fmaxf(am4.w, fabsf(v[i].w) * g[i]);
                }
            }
        }
        *(f32x4*)(red + rr * 64 + c4) = am4;
        __syncthreads();
        if (tid < 64) {
            float a = 0.f;
#pragma unroll
            for (int r = 0; r < 16; ++r) a = fmaxf(a, red[r * 64 + tid]);
            qs[tid] = a > 0.f ? 127.f / a : 0.f;
            if (kb == 0) ((float*)(ws + WS_SW))[n0 + tid] = a * (1.f / 127.f);
        }
        __syncthreads();
        {
            const f32x4 q4 = *(const f32x4*)(qs + c4);
#pragma unroll
            for (int i = 0; i < 8; ++i) {
                const int kl = i * 16 + rr, k = kb * 128 + kl;
                f32x4 v = (f32x4){0.f, 0.f, 0.f, 0.f};
                if (col >= 0) v = *(const f32x4*)(W + (size_t)k * NPROJ_SRC + col);
                const float g = gn[k];
                t8[(c4 + 0) * 144 + kl] = (unsigned char)(int)rintf(v.x * g * q4.x);
                t8[(c4 + 1) * 144 + kl] = (unsigned char)(int)rintf(v.y * g * q4.y);
                t8[(c4 + 2) * 144 + kl] = (unsigned char)(int)rintf(v.z * g * q4.z);
                t8[(c4 + 3) * 144 + kl] = (unsigned char)(int)rintf(v.w * g * q4.w);
            }
        }
        __syncthreads();
        {
            const int nn = tid >> 2, kq = tid & 3;
            const u32x4 o0 = *(const u32x4*)(t8 + nn * 144 + kq * 32), o1 = *(const u32x4*)(t8 + nn * 144 + kq * 32 + 16);
            u32x4* d = (u32x4*)(ws + WS_WIN + (size_t)(n0 + nn) * 1024 + kb * 128 + kq * 32);
            d[0] = o0; d[1] = o1;
        }
        __syncthreads();
    }
    for (int u = bid; u < 16 * 16; u += nb)
        transpose_unit(P.in[18], 1024, 1024, (bf16_t*)(ws + WS_WOUT), (u / 16) * 64, (u % 16) * 64, false, P.in[17], P.in[16], 512, tile);
    for (int u = bid; u < 512; u += nb) {
        const int h2 = u >> 5;
        float* ks = tile;
        float* wq = tile + 128 * 129;
        const float* keys = P.in[21] + (size_t)h2 * 16384;
        for (int i = tid; i < 4096; i += NTHR) {
            const f32x4 a = *(const f32x4*)(keys + i * 4);
            float* d = ks + (i >> 5) * 129 + (i & 31) * 4;
            d[0] = a.x; d[1] = a.y; d[2] = a.z; d[3] = a.w;
        }
#pragma unroll 1
        for (int m = 0; m < 2; ++m) {
            const int k0 = ((u & 31) * 2 + m) * 16;
            for (int i = tid; i < 512; i += NTHR)
                *(f32x4*)(wq + (i >> 5) * 128 + (i & 31) * 4) = *(const f32x4*)(P.in[20] + (size_t)(k0 + (i >> 5)) * 2048 + h2 * 128 + (i & 31) * 4);
            __syncthreads();
            const int key = tid & 127, kh = tid >> 7;
            float aw[8];
#pragma unroll
            for (int j = 0; j < 8; ++j) aw[j] = 0.f;
#pragma unroll 2
            for (int d = 0; d < 128; d += 4) {
                const float a0 = ks[key * 129 + d], a1 = ks[key * 129 + d + 1], a2 = ks[key * 129 + d + 2], a3 = ks[key * 129 + d + 3];
#pragma unroll
                for (int j = 0; j < 8; ++j) {
                    const f32x4 wv = *(const f32x4*)(wq + (kh * 8 + j) * 128 + d);
                    aw[j] += (a0 * wv.x + a1 * wv.y) + (a2 * wv.z + a3 * wv.w);
                }
            }
            const float* g = P.in[19] + k0 + kh * 8;
            *(u32x4*)((bf16_t*)(ws + WS_WQ) + (size_t)(h2 * 128 + key) * 1024 + k0 + kh * 8) =
                (u32x4){pk_bf16(aw[0] * g[0], aw[1] * g[1]), pk_bf16(aw[2] * g[2], aw[3] * g[3]), pk_bf16(aw[4] * g[4], aw[5] * g[5]), pk_bf16(aw[6] * g[6], aw[7] * g[7])};
            __syncthreads();
        }
    }
#define ROT_BID(off_) ((bid + nb - ((off_) % nb)) % nb)
    for (int u = ROT_BID(256); u < 32 * 4; u += nb)
        transpose_unit(P.in[4], 2048, 256, (bf16_t*)(ws + WS_W1K), (u / 4) * 64, (u % 4) * 64, false, nullptr, nullptr, 0, tile);
    for (int u = ROT_BID(384); u < 32 * 4; u += nb)
        transpose_unit(P.in[8], 2048, 256, (bf16_t*)(ws + WS_W1V), (u / 4) * 64, (u % 4) * 64, false, nullptr, nullptr, 0, tile);
    for (int u = ROT_BID(368); u < 4; u += nb)
        transpose_unit(P.in[6], 256, 64, (bf16_t*)(ws + WS_W2K), u * 64, 0, false, nullptr, nullptr, 0, tile);
    for (int u = ROT_BID(372); u < 4; u += nb)
        transpose_unit(P.in[10], 256, 64, (bf16_t*)(ws + WS_W2V), u * 64, 0, false, nullptr, nullptr, 0, tile);
    {
        const float* x = P.in[0];
        unsigned char* xn8 = ws + WS_XN;
        float* sxn = (float*)(ws + WS_SXN);
        for (int row0 = (bid * 4 + w) * 4; row0 < T; row0 += nb * 16) {
            f32x4 v[4][4];
#pragma unroll
            for (int rr = 0; rr < 4; ++rr) {
                const f32x4* xr = (const f32x4*)(x + (size_t)(row0 + rr) * D) + lane;
#pragma unroll
                for (int j = 0; j < 4; ++j) v[rr][j] = __builtin_nontemporal_load(xr + 64 * j);
            }
#pragma unroll
            for (int rr = 0; rr < 4; ++rr) {
                float ss = 0.f, am = 0.f;
#pragma unroll
                for (int j = 0; j < 4; ++j) {
                    ss += v[rr][j].x * v[rr][j].x + v[rr][j].y * v[rr][j].y + v[rr][j].z * v[rr][j].z + v[rr][j].w * v[rr][j].w;
                    am = fmaxf(am, fmaxf(fmaxf(fabsf(v[rr][j].x), fabsf(v[rr][j].y)), fmaxf(fabsf(v[rr][j].z), fabsf(v[rr][j].w))));
                }
                ss = wave_sum(ss);
                am = wave_max(am);
                const float rs = rsqrtf(ss * (1.f / D) + EPS);
                const float qs = am > 0.f ? 127.f / am : 0.f;
                unsigned* o = (unsigned*)(xn8 + (size_t)(row0 + rr) * D) + lane;
#pragma unroll
                for (int j = 0; j < 4; ++j) {
                    const int q0 = (int)rintf(v[rr][j].x * qs), q1 = (int)rintf(v[rr][j].y * qs), q2 = (int)rintf(v[rr][j].z * qs), q3 = (int)rintf(v[rr][j].w * qs);
                    o[64 * j] = ((unsigned)q0 & 255u) | (((unsigned)q1 & 255u) << 8) | (((unsigned)q2 & 255u) << 16) | (((unsigned)q3 & 255u) << 24);
                }
                if (lane == 0) { sxn[row0 + rr] = am * rs * (1.f / 127.f); ((float*)(ws + WS_SXR))[row0 + rr] = am * (1.f / 127.f); }
            }
        }
    }
    {
        const float* g = P.in[19];
        unsigned char* U8 = ws + WS_U;
        unsigned char* V8 = ws + WS_V;
        float* SU = (float*)(ws + WS_SU);
        float* SV = (float*)(ws + WS_SV);
        f32x4 gg[4];
#pragma unroll
        for (int q = 0; q < 4; ++q) gg[q] = *(const f32x4*)(g + lane * 16 + 4 * q);
        for (int row0 = (bid * 4 + w) * 4; row0 < 32768; row0 += nb * 16) {
            const bool isv = row0 >= 16384;
            const int e0 = row0 & 16383;
            const float* src = (isv ? P.in[23] : P.in[22]) + (size_t)e0 * 1024 + lane * 16;
            f32x4 v[4][4];
#pragma unroll
            for (int rr = 0; rr < 4; ++rr)
#pragma unroll
                for (int q = 0; q < 4; ++q) v[rr][q] = *(const f32x4*)(src + (size_t)rr * 1024 + 4 * q);
#pragma unroll
            for (int rr = 0; rr < 4; ++rr) {
                const int e = e0 + rr;
                if (!isv) {
#pragma unroll
                    for (int q = 0; q < 4; ++q) { v[rr][q].x *= gg[q].x; v[rr][q].y *= gg[q].y; v[rr][q].z *= gg[q].z; v[rr][q].w *= gg[q].w; }
                }
                float am = 0.f, sq = 0.f;
#pragma unroll
                for (int q = 0; q < 4; ++q) {
                    am = fmaxf(am, fmaxf(fmaxf(fabsf(v[rr][q].x), fabsf(v[rr][q].y)), fmaxf(fabsf(v[rr][q].z), fabsf(v[rr][q].w))));
                    sq += (v[rr][q].x * v[rr][q].x + v[rr][q].y * v[rr][q].y) + (v[rr][q].z * v[rr][q].z + v[rr][q].w * v[rr][q].w);
                }
                am = wave_max(am);
                const float qmax = isv ? 6.f : 7.f;
                if (!isv) {
                    const float rms = sqrtf(wave_sum(sq) * (1.f / 1024.f));
                    am = fminf(am, 7.f * 0.36f * rms);
                }
                const float sc = am > 0.f ? qmax / am : 1.f;
                unsigned pk[4];
#pragma unroll
                for (int q = 0; q < 4; ++q) {
                    if (isv) {
                        if ((q & 1) == 0) {
                            pk[q >> 1] = __builtin_amdgcn_cvt_scalef32_pk_fp4_f32(0u, v[rr][q].x * sc, v[rr][q].y * sc, 1.0f, 0);
                            pk[q >> 1] = __builtin_amdgcn_cvt_scalef32_pk_fp4_f32(pk[q >> 1], v[rr][q].z * sc, v[rr][q].w * sc, 1.0f, 1);
                        } else {
                            pk[q >> 1] = __builtin_amdgcn_cvt_scalef32_pk_fp4_f32(pk[q >> 1], v[rr][q].x * sc, v[rr][q].y * sc, 1.0f, 2);
                            pk[q >> 1] = __builtin_amdgcn_cvt_scalef32_pk_fp4_f32(pk[q >> 1], v[rr][q].z * sc, v[rr][q].w * sc, 1.0f, 3);
                        }
                    } else {
                        const int q0 = (int)fminf(fmaxf(rintf(v[rr][q].x * sc), -7.f), 7.f), q1 = (int)fminf(fmaxf(rintf(v[rr][q].y * sc), -7.f), 7.f);
                        const int q2 = (int)fminf(fmaxf(rintf(v[rr][q].z * sc), -7.f), 7.f), q3 = (int)fminf(fmaxf(rintf(v[rr][q].w * sc), -7.f), 7.f);
                        const unsigned h16 = ((unsigned)q0 & 15u) | (((unsigned)q1 & 15u) << 4) | (((unsigned)q2 & 15u) << 8) | (((unsigned)q3 & 15u) << 12);
                        if ((q & 1) == 0) pk[q >> 1] = h16; else pk[q >> 1] |= h16 << 16;
                    }
                }
                *(u32x2*)((isv ? V8 : U8) + (size_t)(lane >> 4) * (16384 * 128) + (size_t)e * 128 + (lane & 15) * 8) = (u32x2){pk[0], pk[1]};
                if (lane == 0) (isv ? SV : SU)[e] = am > 0.f ? am / qmax : 1.f;
            }
        }
    }
    for (int u = ROT_BID(376); u < 8; u += nb) {
        const int kv = u >> 2, n = (u & 3) * 64 + (tid & 63), kq = tid >> 6;
        const float* pos = P.in[kv ? 7 : 3];
        const float* w1 = P.in[kv ? 8 : 4];
        const float* b1 = P.in[kv ? 9 : 5];
        float* bo = (float*)(ws + (kv ? WS_BIASV : WS_BIASK));
        float a0 = 0.f, a1 = 0.f, a2 = 0.f, a3 = 0.f;
#pragma unroll 4
        for (int k = kq * 512; k < kq * 512 + 512; k += 4) {
            a0 += pos[k] * w1[(size_t)k * 256 + n];
            a1 += pos[k + 1] * w1[(size_t)(k + 1) * 256 + n];
            a2 += pos[k + 2] * w1[(size_t)(k + 2) * 256 + n];
            a3 += pos[k + 3] * w1[(size_t)(k + 3) * 256 + n];
        }
        tile[tid] = (a0 + a1) + (a2 + a3);
        __syncthreads();
        if (tid < 64) bo[n] = b1[n] + (tile[tid] + tile[tid + 64]) + (tile[tid + 128] + tile[tid + 192]);
        __syncthreads();
    }
    {
        float* rt = (float*)(ws + WS_ROPE);
        for (int i = bid * NTHR + tid; i < 4096 * 8; i += nb * NTHR) {
            const int s = i >> 3, f = i & 7;
            const float inv = powf(500000.0f, -(float)f * 2.0f / 16.0f);
            const float ang = (float)s * inv;
            rt[s * 16 + f] = cosf(ang);
            rt[s * 16 + 8 + f] = sinf(ang);
        }
    }
}

struct EpiInProj {
    int m0, nt;
    unsigned char* ws;
    const float* dt_bias;
    unsigned char* stage;
    template <int TT> DEVFI void hook(int, f32x16 (&)[2][TT]) const {}
    template <int TT> DEVFI void operator()(f32x16 (&acc)[2][TT], int wm, int wn, int lane) const {
        const int h5 = lane >> 5, r = lane & 31;
        bf16_t* st = (bf16_t*)(stage + (wm * 2 + wn) * 6144);
        const int tok0 = m0 + wm * 32 * TT;
        const int b = tok0 >> 12;
        if (nt == 22) {
            if (wn == 0) {
#pragma unroll
                for (int tt = 0; tt < TT; ++tt) {
                    const int tok = tok0 + tt * 32 + r;
                    float* gp = (float*)(ws + WS_GATES) + (size_t)tok * 24;
#pragma unroll
                    for (int gq = 0; gq < 3; ++gq) {
                        f32x4 v;
#pragma unroll
                        for (int e = 0; e < 4; ++e) v[e] = sigmoidf_(acc[0][tt][4 * gq + e]);
                        *(f32x4*)(gp + 8 * gq + 4 * h5) = v;
                    }
                    f32x4 v;
#pragma unroll
                    for (int e = 0; e < 4; ++e) v[e] = softplusf_(acc[0][tt][12 + e] + dt_bias[4 * h5 + e]);
                    *(f32x4*)((float*)(ws + WS_DT) + (size_t)tok * 8 + 4 * h5) = v;
                }
            }
            return;
        }
        const bool is_q = nt < 4;
        const bool rope = is_q || nt == 4 || nt == 6 || nt == 8;
        const bool transposed = (nt == 7 || nt == 9);
        const float sc = is_q ? 0.125f * 1.4426950408889634f : 1.f;
        bf16_t* dst; int rstride;
        if (is_q) { dst = (bf16_t*)(ws + WS_Q) + ((size_t)(b * 8 + nt * 2 + wn) * 4096 + (tok0 & 4095)) * 64; rstride = 64; }
        else if (nt < 10) {
            const size_t off = (nt == 4) ? WS_KC : (nt == 5) ? WS_VC : (nt == 6) ? WS_KS : (nt == 7) ? WS_VST : (nt == 8) ? WS_KW : WS_VWT;
            if (transposed) { dst = (bf16_t*)(ws + off) + (size_t)(b * 2 + wn) * 64 * 4096 + (tok0 & 4095); rstride = 4096; }
            else { dst = (bf16_t*)(ws + off) + ((size_t)(b * 2 + wn) * 4096 + (tok0 & 4095)) * 64; rstride = 64; }
        }
        else if (nt < 14) { dst = (bf16_t*)(ws + WS_Z) + (size_t)tok0 * 512 + (nt - 10) * 128 + wn * 64; rstride = 512; }
        else { dst = (bf16_t*)(ws + WS_XBC) + (size_t)tok0 * 1024 + (nt - 14) * 128 + wn * 64; rstride = 1024; }
#pragma unroll
        for (int tt = 0; tt < TT; ++tt) {
            if (rope) {
                const int s = (tok0 + tt * 32 + r) & 4095;
                const float* rt = (const float*)(ws + WS_ROPE) + s * 16 + 4 * h5;
                const f32x4 c = *(const f32x4*)rt, sn = *(const f32x4*)(rt + 8);
#pragma unroll
                for (int e = 0; e < 4; ++e) {
                    const float x1 = acc[0][tt][e], x2 = acc[0][tt][4 + e];
                    acc[0][tt][e] = x1 * c[e] - x2 * sn[e];
                    acc[0][tt][4 + e] = x2 * c[e] + x1 * sn[e];
                }
            }
            if (!transposed) {
#pragma unroll
                for (int ft = 0; ft < 2; ++ft)
#pragma unroll
                    for (int gq = 0; gq < 4; ++gq)
                        *(u32x2*)(st + r * 72 + ft * 32 + 8 * gq + 4 * h5) = (u32x2){pk_bf16(acc[ft][tt][4 * gq] * sc, acc[ft][tt][4 * gq + 1] * sc),
                                                                                   pk_bf16(acc[ft][tt][4 * gq + 2] * sc, acc[ft][tt][4 * gq + 3] * sc)};
#pragma unroll
                for (int i = 0; i < 4; ++i) {
                    const int row = i * 8 + (lane >> 3), c8 = (lane & 7) * 8;
                    *(u32x4*)(dst + (size_t)(tt * 32 + row) * rstride + c8) = *(const u32x4*)(st + row * 72 + c8);
                }
            } else {
                const int pr = (r & ~15) + perm16(r & 15);
#pragma unroll
                for (int ft = 0; ft < 2; ++ft)
#pragma unroll
                    for (int i = 0; i < 16; ++i) {
                        const int d = ft * 32 + 8 * (i >> 2) + 4 * h5 + (i & 3);
                        st[d * 40 + pr] = f2bf(acc[ft][tt][i]);
                    }
#pragma unroll
                for (int i = 0; i < 4; ++i) {
                    const int drow = i * 16 + (lane >> 2), c8 = (lane & 3) * 8;
                    *(u32x4*)(dst + (size_t)drow * 4096 + tt * 32 + c8) = *(const u32x4*)(st + drow * 40 + c8);
                }
            }
        }
    }
};

template <int TT> struct EpiCompress {
    const float* bias;
    bf16_t* Hs;
    DEVFI void hook(int, f32x16 (&)[2][TT]) const {}
    DEVFI void operator()(f32x16 (&acc)[2][TT], int wm, int wn, int lane) const {
        const int h5 = lane >> 5, r = lane & 31;
#pragma unroll
        for (int tt = 0; tt < TT; ++tt) {
            const int row = wm * 32 * TT + tt * 32 + r;
#pragma unroll
            for (int ft = 0; ft < 2; ++ft)
#pragma unroll
                for (int gq = 0; gq < 4; ++gq) {
                    const int f0 = wn * 64 + ft * 32 + 8 * gq + 4 * h5;
                    const f32x4 bv = *(const f32x4*)(bias + f0);
                    float v[4];
#pragma unroll
                    for (int e = 0; e < 4; ++e) v[e] = gelu_tanh(acc[ft][tt][4 * gq + e] + bv[e]);
                    *(u32x2*)(Hs + row * 136 + f0) = (u32x2){pk_bf16(v[0], v[1]), pk_bf16(v[2], v[3])};
                }
        }
    }
};
DEVFI void compress_item(const Params& P_, int item, unsigned char* smem) {
    const int kv = item >> 7, rt = item & 127;
    size_t zoff_ = 0; asm volatile("" : "+s"(zoff_)); const Params& P = *(const Params*)((const char*)&P_ + zoff_); unsigned char* ws = P.ws + zoff_;
    const int tid = threadIdx.x, lane = tid & 63, w = tid >> 6;
    const bf16_t* A = (const bf16_t*)(ws + (kv ? WS_VC : WS_KC)) + (size_t)rt * 64 * 1024;
    const bf16_t* W2t = (const bf16_t*)(ws + (kv ? WS_W2V : WS_W2K));
    const int r = lane & 31, h5 = lane >> 5;
    const int rtile = w & 1, ft = w >> 1;
    f32x16 o = zero16();
#pragma unroll 1
    for (int nh = 0; nh < 2; ++nh) {
        const bf16_t* Bt = (const bf16_t*)(ws + (kv ? WS_W1V : WS_W1K)) + (size_t)nh * 128 * 2048;
        EpiCompress<1> epi;
        epi.bias = (const float*)(ws + (kv ? WS_BIASV : WS_BIASK)) + nh * 128;
        epi.Hs = (bf16_t*)smem;
        gemm_tile<2, 1, 2, false>(A, 1024, Bt, 2048, 32, smem, epi);
        __syncthreads();
#pragma unroll
        for (int ks = 0; ks < 8; ++ks) {
            const bf16x8 fb = *(const bf16x8*)(epi.Hs + (32 * rtile + r) * 136 + ks * 16 + 8 * h5);
            const bf16x8 fa = *(const bf16x8*)(W2t + (size_t)(ft * 32 + r) * 256 + nh * 128 + ks * 16 + 8 * h5);
            o = mfma32(fa, fb, o);
        }
        __syncthreads();
    }
    const int R = rt * 64 + 32 * rtile + r;
    const bool dead = (R & 255) == 255;
    if (dead) o = zero16();
    if (kv == 0) {
        bf16_t* dst = (bf16_t*)(ws + WS_KCP) + (size_t)R * 64 + ft * 32 + 4 * h5;
#pragma unroll
        for (int gq = 0; gq < 4; ++gq) *(u32x2*)(dst + 8 * gq) = (u32x2){pk_bf16(o[4 * gq], o[4 * gq + 1]), pk_bf16(o[4 * gq + 2], o[4 * gq + 3])};
    } else {
        const int bgi = R >> 8, j = R & 255, jp = (j & ~15) + perm16(j & 15);
        bf16_t* dst = (bf16_t*)(ws + WS_KCP + MiB) + ((size_t)bgi * 64 + ft * 32 + 4 * h5) * 256 + jp;
#pragma unroll
        for (int i = 0; i < 16; ++i) dst[(size_t)(8 * (i >> 2) + (i & 3)) * 256] = f2bf(o[i]);
    }
}

constexpr int KS72 = 72;
DEVFI void nsa_qk(const bf16_t* kb, int kt2, const bf16x8 (&qf)[2][4], f32x16 (&st)[2], int r, int h5) {
    st[0] = zero16(); st[1] = zero16();
#pragma unroll
    for (int ks = 0; ks < 4; ++ks) {
        const bf16x8 fa = *(const bf16x8*)(kb + (kt2 * 32 + r) * KS72 + ks * 16 + 8 * h5);
#pragma unroll
        for (int tt = 0; tt < 2; ++tt) st[tt] = mfma32(fa, qf[tt][ks], st[tt]);
    }
}
DEVFI void nsa_pv(const bf16_t* vb, int kt2, const f32x16 (&st)[2], f32x16 (&O)[2][2], int r, int h5) {
#pragma unroll
    for (int s2 = 0; s2 < 2; ++s2) {
        bf16x8 pf[2];
#pragma unroll
        for (int tt = 0; tt < 2; ++tt) {
            union { bf16x8 v; unsigned u[4]; } cv;
#pragma unroll
            for (int j = 0; j < 4; ++j) cv.u[j] = pk_bf16(st[tt][8 * s2 + 2 * j], st[tt][8 * s2 + 2 * j + 1]);
            pf[tt] = cv.v;
        }
#pragma unroll
        for (int dt = 0; dt < 2; ++dt) {
            const bf16x8 fa = *(const bf16x8*)(vb + (dt * 32 + r) * KS72 + kt2 * 32 + s2 * 16 + 8 * h5);
#pragma unroll
            for (int tt = 0; tt < 2; ++tt) O[dt][tt] = mfma32(fa, pf[tt], O[dt][tt]);
        }
    }
}
template <bool WITH_O>
DEVFI void nsa_softmax(f32x16 (&st)[2], int kt2, int lo, int hi, float (&mrun)[2], float (&lrun)[2], f32x16 (&O)[2][2], int h5) {
    float mx[2] = {-1e30f, -1e30f};
#pragma unroll
    for (int i = 0; i < 16; ++i) {
        const int keyl = kt2 * 32 + 8 * (i >> 2) + 4 * h5 + (i & 3);
        const bool ok = (keyl > lo) && (keyl <= hi);
#pragma unroll
        for (int tt = 0; tt < 2; ++tt) { const float sv = ok ? st[tt][i] : -1e30f; st[tt][i] = sv; mx[tt] = fmaxf(mx[tt], sv); }
    }
    float alpha[2];
#pragma unroll
    for (int tt = 0; tt < 2; ++tt) {
        mx[tt] = fmaxf(mx[tt], xor32f(mx[tt]));
        const float mn = fmaxf(mrun[tt], mx[tt]);
        alpha[tt] = __builtin_amdgcn_exp2f(mrun[tt] - mn);
        mrun[tt] = mn;
        float rs_ = 0.f;
#pragma unroll
        for (int i = 0; i < 16; ++i) {
            const float sv = st[tt][i];
            const float p = (sv > -1e29f) ? __builtin_amdgcn_exp2f(sv - mn) : 0.f;
            st[tt][i] = p; rs_ += p;
        }
        rs_ += xor32f(rs_);
        lrun[tt] = lrun[tt] * alpha[tt] + rs_;
    }
    if (WITH_O) {
        if (__any(alpha[0] != 1.f || alpha[1] != 1.f)) {
#pragma unroll
            for (int tt = 0; tt < 2; ++tt)
#pragma unroll
                for (int dt = 0; dt < 2; ++dt)
#pragma unroll
                    for (int i = 0; i < 16; ++i) O[dt][tt][i] *= alpha[tt];
        }
    }
}

DEVFI void nsa_softmax_fast(f32x16 (&st)[2], bool lane_ok, float (&mrun)[2], float (&lrun)[2], f32x16 (&O)[2][2]) {
    float alpha[2];
#pragma unroll
    for (int tt = 0; tt < 2; ++tt) {
        float mx = fmaxf(fmaxf(st[tt][0], st[tt][1]), fmaxf(st[tt][2], st[tt][3]));
#pragma unroll
        for (int i = 4; i < 16; i += 4) mx = fmaxf(mx, fmaxf(fmaxf(st[tt][i], st[tt][i + 1]), fmaxf(st[tt][i + 2], st[tt][i + 3])));
        mx = fmaxf(mx, xor32f(mx));
        mx = lane_ok ? mx : -1e30f;
        const float mn = fmaxf(mrun[tt], mx);
        alpha[tt] = __builtin_amdgcn_exp2f(mrun[tt] - mn);
        mrun[tt] = mn;
        const float msub = lane_ok ? mn : 1e30f;
        float rs0 = 0.f, rs1 = 0.f;
#pragma unroll
        for (int i = 0; i < 16; i += 2) {
            const float p0 = __builtin_amdgcn_exp2f(st[tt][i] - msub), p1 = __builtin_amdgcn_exp2f(st[tt][i + 1] - msub);
            st[tt][i] = p0; st[tt][i + 1] = p1; rs0 += p0; rs1 += p1;
        }
        float rs_ = rs0 + rs1;
        rs_ += xor32f(rs_);
        lrun[tt] = lrun[tt] * alpha[tt] + rs_;
    }
    if (__any(alpha[0] != 1.f || alpha[1] != 1.f)) {
#pragma unroll
        for (int tt = 0; tt < 2; ++tt)
#pragma unroll
            for (int dt = 0; dt < 2; ++dt)
#pragma unroll
                for (int i = 0; i < 16; ++i) O[dt][tt][i] *= alpha[tt];
    }
}

DEVFI void nsa_item(const Params& P_, int bg, int qb, unsigned char* smem, const int variant) {
    size_t zoff_ = 0; asm volatile("" : "+s"(zoff_)); const Params& P = *(const Params*)((const char*)&P_ + zoff_); unsigned char* ws = P.ws + zoff_;
    int tid = threadIdx.x; asm volatile("" : "+v"(tid));
    const int lane = tid & 63, w = tid >> 6;
    const int b = bg >> 1, g = bg & 1;
    bf16_t* sK = (bf16_t*)smem;
    bf16_t* sV = sK + 2 * 64 * KS72;
    float* sA = (float*)(sV + 2 * 64 * KS72);
    float* sL = sA + 64 * 65;
    unsigned* sM = (unsigned*)(sL + 64 * 65);
    bf16_t* sO = (bf16_t*)sA;
    const int r = lane & 31, h5 = lane >> 5, rl = (lane >> 4) & 1;
    const int tl = 16 * w + (lane & 15);
    const int tq = qb * 64 + tl;
    const size_t tok = (size_t)b * 4096 + tq;

    bf16x8 qf[2][4];
#define NSA_LOAD_Q() do { _Pragma("unroll") for (int tt = 0; tt < 2; ++tt) { \
        const int head = g * 4 + 2 * tt + rl; \
        const bf16_t* qp = (const bf16_t*)(ws + WS_Q) + ((size_t)(b * 8 + head) * 4096 + tq) * 64 + 8 * h5; \
        _Pragma("unroll") for (int ks = 0; ks < 4; ++ks) qf[tt][ks] = *(const bf16x8*)(qp + ks * 16); } } while (0)
    NSA_LOAD_Q();
    const int lrow = tid >> 3, lkc = (tid & 7) * 8;

    f32x16 O[2][2];
    float mrun[2], lrun[2];
#define NSA_RESET() do { _Pragma("unroll") for (int a_ = 0; a_ < 2; ++a_) { mrun[a_] = -1e30f; lrun[a_] = 0.f; _Pragma("unroll") for (int b_ = 0; b_ < 2; ++b_) O[a_][b_] = zero16(); } } while (0)

    const int jmax = (tq - 31) >> 4;
    const int n_ct = ((4 * qb + 2) >> 6) + 1;
    const bool need_sel = qb >= 16;
    const bf16_t* kcb = (const bf16_t*)(ws + WS_KCP) + (size_t)bg * 256 * 64;
    const bf16_t* vct = (const bf16_t*)(ws + WS_KCP + MiB) + (size_t)bg * 64 * 256;
    u32x4 ck0_, ck1_, cv0_, cv1_;
#define NSA_FETCH_CMP(ct) do { \
        const int j_ = tid >> 2, dq_ = (tid & 3) * 16; \
        const bf16_t* ks_ = kcb + (size_t)((ct) * 64 + j_) * 64 + dq_; \
        const bf16_t* vs_ = vct + (size_t)j_ * 256 + (ct) * 64 + dq_; \
        ck0_ = *(const u32x4*)ks_; ck1_ = *(const u32x4*)(ks_ + 8); cv0_ = *(const u32x4*)vs_; cv1_ = *(const u32x4*)(vs_ + 8); } while (0)
#define NSA_STORE_CMP() do { \
        const int j_ = tid >> 2, dq_ = (tid & 3) * 16; \
        *(u32x4*)(sK + j_ * KS72 + dq_) = ck0_; *(u32x4*)(sK + j_ * KS72 + dq_ + 8) = ck1_; \
        *(u32x4*)(sV + j_ * KS72 + dq_) = cv0_; *(u32x4*)(sV + j_ * KS72 + dq_ + 8) = cv1_; } while (0)

    NSA_RESET();
    NSA_FETCH_CMP(0);
#pragma unroll 1
    for (int ct = 0; ct < n_ct; ++ct) {
        __syncthreads();
        NSA_STORE_CMP();
        NSA_FETCH_CMP(ct + 1 < n_ct ? ct + 1 : 0);
        __syncthreads();
        const int hi = jmax - ct * 64;
#pragma unroll 1
        for (int kt2 = 0; kt2 < 2; ++kt2) {
            f32x16 st[2];
            nsa_qk(sK, kt2, qf, st, r, h5);
            nsa_softmax<false>(st, kt2, -1, hi, mrun, lrun, O, h5);
        }
    }
    float mfin[2], linv[2];
#pragma unroll
    for (int tt = 0; tt < 2; ++tt) { mfin[tt] = mrun[tt]; linv[tt] = lrun[tt] > 0.f ? 1.f / lrun[tt] : 0.f; }
#pragma unroll 1
    for (int ct = 0; ct < n_ct; ++ct) {
        __syncthreads();
        NSA_STORE_CMP();
        if (ct + 1 < n_ct) NSA_FETCH_CMP(ct + 1);
        __syncthreads();
        const int hi = jmax - ct * 64;
#pragma unroll 1
        for (int kt2 = 0; kt2 < 2; ++kt2) {
            f32x16 st[2];
            nsa_qk(sK, kt2, qf, st, r, h5);
#pragma unroll
            for (int i = 0; i < 16; ++i) {
                const int keyl = kt2 * 32 + 8 * (i >> 2) + 4 * h5 + (i & 3);
                const bool ok = keyl <= hi;
#pragma unroll
                for (int tt = 0; tt < 2; ++tt)
                    st[tt][i] = ok ? __builtin_amdgcn_exp2f(st[tt][i] - mfin[tt]) * linv[tt] : 0.f;
            }
            if (need_sel) {
#pragma unroll
                for (int c = 0; c < 4; ++c) {
                    float pt[4];
#pragma unroll
                    for (int e = 0; e < 4; ++e) { const float v = st[0][4 * c + e] + st[1][4 * c + e]; pt[e] = v + xor16f(v); }
                    if (rl == 0) {
                        const int blk = ct * 16 + kt2 * 8 + 2 * c + h5;
                        sA[tl * 65 + blk] = (pt[0] + pt[1]) + (pt[2] + pt[3]);
                        sL[tl * 65 + blk] = pt[3];
                    }
                }
            }
            nsa_pv(sV, kt2, st, O, r, h5);
        }
    }
    __syncthreads();
    const float* gatep = (const float*)(ws + WS_GATES) + tok * 24 + (g * 4 + rl) * 3;
    bf16_t* tmpO = sK + (size_t)(w * 64) * 64;
#pragma unroll
    for (int tt = 0; tt < 2; ++tt)
#pragma unroll
        for (int dt = 0; dt < 2; ++dt)
#pragma unroll
            for (int gq = 0; gq < 4; ++gq) {
                const int d0 = dt * 32 + 8 * gq + 4 * h5;
                const float gsc = gatep[tt * 6];
                *(u32x2*)(tmpO + (tt * 32 + r) * 64 + d0) = (u32x2){pk_bf16(O[dt][tt][4 * gq] * gsc, O[dt][tt][4 * gq + 1] * gsc),
                                                                    pk_bf16(O[dt][tt][4 * gq + 2] * gsc, O[dt][tt][4 * gq + 3] * gsc)};
            }
    if (need_sel) {
        const int t4 = tid >> 2, qd = tid & 3;
        float cand[16];
#pragma unroll
        for (int e = 0; e < 16; ++e) {
            const int i = 1 + qd + 4 * e;
            cand[e] = (i <= qb - 2) ? sA[t4 * 65 + i] + sL[t4 * 65 + i - 1] : -1.f;
        }
        __syncthreads();
#pragma unroll
        for (int e = 0; e < 16; ++e) { const int i = 1 + qd + 4 * e; if (i < 65) sA[t4 * 65 + i] = cand[e]; }
        __syncthreads();
        int rank[16];
#pragma unroll
        for (int e = 0; e < 16; ++e) rank[e] = 0;
#pragma unroll 1
        for (int ip = 1; ip <= qb - 2; ++ip) {
            const float v = sA[t4 * 65 + ip];
#pragma unroll
            for (int e = 0; e < 16; ++e) {
                const int i = 1 + qd + 4 * e;
                rank[e] += (v > cand[e] || (v == cand[e] && ip < i)) ? 1 : 0;
            }
        }
        unsigned lo = 0u, hi = 0u;
#pragma unroll
        for (int e = 0; e < 16; ++e) {
            const int i = 1 + qd + 4 * e;
            if (i <= qb - 2 && rank[e] < 13) { if (i < 32) lo |= 1u << i; else hi |= 1u << (i - 32); }
        }
        lo |= dpp_u<0xB1>(lo); hi |= dpp_u<0xB1>(hi);
        lo |= dpp_u<0x4E>(lo); hi |= dpp_u<0x4E>(hi);
        lo |= 1u;
        if (qb < 32) lo |= 1u << qb; else hi |= 1u << (qb - 32);
        if (qb - 1 < 32) lo |= 1u << (qb - 1); else hi |= 1u << (qb - 33);
        if (qd == 0) { sM[t4 * 2] = lo; sM[t4 * 2 + 1] = hi; }
    } else {
        if (tid < 64) {
            const unsigned long long mk = (2ull << qb) - 1ull;
            sM[tid * 2] = (unsigned)mk; sM[tid * 2 + 1] = (unsigned)(mk >> 32);
        }
    }
    __syncthreads();
    const unsigned selLo = sM[tl * 2], selHi = sM[tl * 2 + 1];
    bf16_t* myO = sO + (size_t)(w * 64) * 64;
#pragma unroll
    for (int tt = 0; tt < 2; ++tt)
#pragma unroll
        for (int q8 = 0; q8 < 4; ++q8) {
            const int off = (tt * 32 + r) * 64 + q8 * 16 + 8 * h5;
            *(u32x4*)(myO + off) = *(const u32x4*)(tmpO + off);
        }
    NSA_LOAD_Q();
    __syncthreads();

#pragma unroll 1
    for (int br = 0; br < 2; ++br) {
        const bf16_t* Kg = (const bf16_t*)(ws + (br == 0 ? WS_KS : WS_KW)) + (size_t)bg * 4096 * 64;
        const bf16_t* Vg = (const bf16_t*)(ws + (br == 0 ? WS_VST : WS_VWT)) + (size_t)bg * 64 * 4096;
        const int i_lo = (br == 0) ? 0 : (qb >= 8 ? qb - 8 : 0);
        NSA_RESET();
        u32x4 rk[2], rv[2];
#pragma unroll
        for (int i = 0; i < 2; ++i) {
            rk[i] = *(const u32x4*)(Kg + (size_t)(i_lo * 64 + lrow + 32 * i) * 64 + lkc);
            rv[i] = *(const u32x4*)(Vg + (size_t)(lrow + 32 * i) * 4096 + i_lo * 64 + lkc);
        }
#pragma unroll 1
        for (int it = i_lo; it <= qb; ++it) {
            const int buf = (it - i_lo) & 1;
            bf16_t* kb = sK + buf * 64 * KS72;
            bf16_t* vb = sV + buf * 64 * KS72;
#pragma unroll
            for (int i = 0; i < 2; ++i) {
                *(u32x4*)(kb + (lrow + 32 * i) * KS72 + lkc) = rk[i];
                *(u32x4*)(vb + (lrow + 32 * i) * KS72 + lkc) = rv[i];
            }
            __syncthreads();
            if (it < qb && variant != 3) {
#pragma unroll
                for (int i = 0; i < 2; ++i) {
                    rk[i] = *(const u32x4*)(Kg + (size_t)((it + 1) * 64 + lrow + 32 * i) * 64 + lkc);
                    rv[i] = *(const u32x4*)(Vg + (size_t)(lrow + 32 * i) * 4096 + (it + 1) * 64 + lkc);
                }
            }
            int lo = -1, hi = 63;
            if (it == qb) hi = tl;
            bool lane_ok = true;
            if (br == 0) {
                const unsigned bit = (it < 32) ? (selLo >> it) & 1u : (selHi >> (it - 32)) & 1u;
                if (!bit) { hi = -1; lane_ok = false; }
            } else {
                if (it == qb - 8) lo = tl;
            }
            const bool boundary = (it == qb) || (br == 1 && it == qb - 8);
            if (__any(hi > lo)) {
                if (boundary) {
#pragma unroll 1
                    for (int kt2 = 0; kt2 < 2; ++kt2) {
                        f32x16 st[2];
                        nsa_qk(kb, kt2, qf, st, r, h5);
                        __builtin_amdgcn_sched_barrier(0);
                        nsa_softmax<true>(st, kt2, lo, hi, mrun, lrun, O, h5);
                        __builtin_amdgcn_sched_barrier(0);
                        nsa_pv(vb, kt2, st, O, r, h5);
                        __builtin_amdgcn_sched_barrier(0);
                    }
                } else if (variant != 4) {
#pragma unroll 1
                    for (int kt2 = 0; kt2 < 2; ++kt2) {
                        f32x16 st[2];
                        nsa_qk(kb, kt2, qf, st, r, h5);
                        __builtin_amdgcn_sched_barrier(0);
                        if (variant != 2) nsa_softmax_fast(st, lane_ok, mrun, lrun, O);
                        __builtin_amdgcn_sched_barrier(0);
                        nsa_pv(vb, kt2, st, O, r, h5);
                        __builtin_amdgcn_sched_barrier(0);
                    }
                }
            }
        }
        __syncthreads();
#pragma unroll
        for (int tt = 0; tt < 2; ++tt) {
            const float gsc = gatep[tt * 6 + 1 + br] * (lrun[tt] > 0.f ? 1.f / lrun[tt] : 0.f);
#pragma unroll
            for (int dt = 0; dt < 2; ++dt)
#pragma unroll
                for (int gq = 0; gq < 4; ++gq) {
                    const int d0 = dt * 32 + 8 * gq + 4 * h5;
                    u32x2* p = (u32x2*)(myO + (tt * 32 + r) * 64 + d0);
                    const u32x2 old = *p;
                    const float v0 = bf_lo(old.x) + O[dt][tt][4 * gq] * gsc, v1 = bf_hi(old.x) + O[dt][tt][4 * gq + 1] * gsc;
                    const float v2 = bf_lo(old.y) + O[dt][tt][4 * gq + 2] * gsc, v3 = bf_hi(old.y) + O[dt][tt][4 * gq + 3] * gsc;
                    if (br == 0) {
                        *p = (u32x2){pk_bf16(v0, v1), pk_bf16(v2, v3)};
                    } else {
                        O[dt][tt][4 * gq] = v0; O[dt][tt][4 * gq + 1] = v1; O[dt][tt][4 * gq + 2] = v2; O[dt][tt][4 * gq + 3] = v3;
                    }
                }
        }
    }
    {
        bf16_t* Am = (bf16_t*)(ws + (variant ? WS_XN : WS_AMAT));
        float* ssn = (float*)(ws + (variant ? WS_X1B : WS_SSN));
#pragma unroll
        for (int tt = 0; tt < 2; ++tt) {
            const int head = g * 4 + 2 * tt + rl;
            float ss = 0.f;
            bf16_t* dst = Am + tok * 1024 + head * 64;
#pragma unroll
            for (int dt = 0; dt < 2; ++dt)
#pragma unroll
                for (int gq = 0; gq < 4; ++gq) {
                    const int d0 = dt * 32 + 8 * gq + 4 * h5;
                    const float v0 = O[dt][tt][4 * gq], v1 = O[dt][tt][4 * gq + 1], v2 = O[dt][tt][4 * gq + 2], v3 = O[dt][tt][4 * gq + 3];
                    ss += v0 * v0 + v1 * v1 + v2 * v2 + v3 * v3;
                    *(u32x2*)(dst + d0) = (u32x2){pk_bf16(v0, v1), pk_bf16(v2, v3)};
                }
            ss += xor32f(ss);
            if (h5 == 0) ssn[tok * 8 + head] = ss;
        }
    }
    __syncthreads();
#undef NSA_RESET
#undef NSA_FETCH_CMP
#undef NSA_STORE_CMP
#undef NSA_LOAD_Q
}

DEVFI void conv_item(const Params& P_, int item) {
    size_t zoff_ = 0; asm volatile("" : "+s"(zoff_)); const Params& P = *(const Params*)((const char*)&P_ + zoff_); unsigned char* ws = P.ws + zoff_;
    int tid = threadIdx.x; asm volatile("" : "+v"(tid));
    const int cc = tid & 127, rq = tid >> 7;
    const int ch = cc * 8;
    const size_t tok0 = (size_t)item * 32 + rq * 16;
    const int s0 = (int)(tok0 & 4095);
    const float* cw = P.in[11];
    const float* cb = P.in[12];
    float wv[4][8], bv[8];
#pragma unroll
    for (int j = 0; j < 4; ++j) { const f32x4 a = *(const f32x4*)(cw + j * 1024 + ch), bq = *(const f32x4*)(cw + j * 1024 + ch + 4);
        wv[j][0] = a.x; wv[j][1] = a.y; wv[j][2] = a.z; wv[j][3] = a.w; wv[j][4] = bq.x; wv[j][5] = bq.y; wv[j][6] = bq.z; wv[j][7] = bq.w; }
    { const f32x4 a = *(const f32x4*)(cb + ch), bq = *(const f32x4*)(cb + ch + 4);
        bv[0] = a.x; bv[1] = a.y; bv[2] = a.z; bv[3] = a.w; bv[4] = bq.x; bv[5] = bq.y; bv[6] = bq.z; bv[7] = bq.w; }
    const bf16_t* src = (const bf16_t*)(ws + WS_XBC) + tok0 * 1024 + ch;
    bf16_t* dst = (bf16_t*)(ws + WS_XBC2) + tok0 * 1024 + ch;
    u32x4 raw[19];
#pragma unroll
    for (int j = 0; j < 19; ++j) {
        const bool z_ = (s0 - 3 + j) < 0;
        raw[j] = z_ ? (u32x4){0u, 0u, 0u, 0u} : *(const u32x4*)(src + ((long)j - 3) * 1024);
    }
#pragma unroll
    for (int q = 0; q < 16; ++q) {
        float o[8];
#pragma unroll
        for (int e = 0; e < 8; ++e) o[e] = bv[e];
#pragma unroll
        for (int j = 0; j < 4; ++j) {
            const u32x4 rw = raw[q + j];
            o[0] += wv[j][0] * bf_lo(rw.x); o[1] += wv[j][1] * bf_hi(rw.x); o[2] += wv[j][2] * bf_lo(rw.y); o[3] += wv[j][3] * bf_hi(rw.y);
            o[4] += wv[j][4] * bf_lo(rw.z); o[5] += wv[j][5] * bf_hi(rw.z); o[6] += wv[j][6] * bf_lo(rw.w); o[7] += wv[j][7] * bf_hi(rw.w);
        }
#pragma unroll
        for (int e = 0; e < 8; ++e) o[e] = siluf_(o[e]);
        *(u32x4*)(dst + (size_t)q * 1024) = (u32x4){pk_bf16(o[0], o[1]), pk_bf16(o[2], o[3]), pk_bf16(o[4], o[5]), pk_bf16(o[6], o[7])};
    }
}

DEVFI int rot64(int pos, int row) { return (pos + 8 * (row >> 3)) & 63; }

DEVFI void ssd_item(const Params& P_, int b, int hd, unsigned char* smem) {
    size_t zoff_ = 0; asm volatile("" : "+s"(zoff_)); const Params& P = *(const Params*)((const char*)&P_ + zoff_); unsigned char* ws = P.ws + zoff_;
    int tid = threadIdx.x; asm volatile("" : "+v"(tid));
    const int lane = tid & 63, w = tid >> 6;
    const int g = hd >> 2;
    const int r = lane & 31, h5 = lane >> 5;
    bf16_t* sC = (bf16_t*)smem;
    bf16_t* sB = sC + 64 * 136;
    bf16_t* sBT = sB + 64 * 136;
    bf16_t* sXT = sBT + 128 * 72;
    bf16_t* sH = sXT + 64 * 72;
    float* sAc = (float*)(sH + 64 * 136);
    float* sDt = sAc + 64;
    const float aneg = -__expf(P.in[14][hd]);
    const float dsk = P.in[15][hd];
    const bf16_t* XB2 = (const bf16_t*)(ws + WS_XBC2);
    const bf16_t* Zb = (const bf16_t*)(ws + WS_Z);
    const float* DT = (const float*)(ws + WS_DT);
    bf16_t* Am = (bf16_t*)(ws + WS_AMAT);
    float* sss = (float*)(ws + WS_SSS);

    f32x16 hacc[2] = {zero16(), zero16()};
    for (int i = tid; i < 64 * 136 / 2; i += NTHR) ((unsigned*)sH)[i] = 0u;

    const int ccb = tid & 15, isC = (tid >> 4) & 1, rg = tid >> 5;
    const int ccx = tid & 7, rgx = tid >> 3;
    const int chBC = 512 + isC * 256 + g * 128 + ccb * 8, chX = hd * 64 + ccx * 8;
    const int lt = w & 1, ph = w >> 1;
    const int lq = lt * 32 + r;

    u32x4 rawBC[8], rawX[2];
    u32x2 zr[4];
    float dtv = 0.f;
    const int toffBC = rg * 8 * 1024 + chBC, toffX = rgx * 2 * 1024 + chX;
    const int toffZ = lq * 512 + hd * 64 + ph * 32 + 4 * h5;
#define SSD_PREFETCH(c_) do { \
        const size_t t0_ = (size_t)b * 4096 + (size_t)(c_) * 64; \
        const bf16_t* xb_ = XB2 + t0_ * 1024; \
        _Pragma("unroll") for (int j = 0; j < 8; ++j) rawBC[j] = *(const u32x4*)(xb_ + (size_t)j * 1024 + toffBC); \
        _Pragma("unroll") for (int j = 0; j < 2; ++j) rawX[j] = *(const u32x4*)(xb_ + (size_t)j * 1024 + toffX); \
        const bf16_t* zb_ = Zb + t0_ * 512 + toffZ; \
        _Pragma("unroll") for (int gq = 0; gq < 4; ++gq) zr[gq] = *(const u32x2*)(zb_ + 8 * gq); \
        dtv = DT[(t0_ + lane) * 8 + hd]; \
    } while (0)
    SSD_PREFETCH(0);

#pragma unroll 1
    for (int c = 0; c < 64; ++c) {
        const size_t tok0 = (size_t)b * 4096 + c * 64;
        if (w == 0) {
            float a = dtv * aneg;
#pragma unroll
            for (int o = 1; o < 64; o <<= 1) { const float t = __shfl_up(a, o); if (lane >= o) a += t; }
            sAc[lane] = a;
            sDt[lane] = dtv;
        }
        __syncthreads();
        const float atot = sAc[63];
#pragma unroll
        for (int q = 0; q < 8; ++q) {
            const int l = rg * 8 + q;
            const u32x4 rw = rawBC[q];
            *(u32x4*)((isC ? sC : sB) + l * 136 + ccb * 8) = rw;
            if (!isC) {
                const float wdec = __expf(atot - sAc[l]);
                const int lp = rot64((l & ~15) + perm16(l & 15), ccb * 8);
                bf16_t* d = sBT + (ccb * 8) * 72 + lp;
                d[0 * 72] = f2bf(bf_lo(rw.x) * wdec); d[1 * 72] = f2bf(bf_hi(rw.x) * wdec); d[2 * 72] = f2bf(bf_lo(rw.y) * wdec); d[3 * 72] = f2bf(bf_hi(rw.y) * wdec);
                d[4 * 72] = f2bf(bf_lo(rw.z) * wdec); d[5 * 72] = f2bf(bf_hi(rw.z) * wdec); d[6 * 72] = f2bf(bf_lo(rw.w) * wdec); d[7 * 72] = f2bf(bf_hi(rw.w) * wdec);
            }
        }
#pragma unroll
        for (int q = 0; q < 2; ++q) {
            const int l = rgx * 2 + q;
            const u32x4 rw = rawX[q];
            const float dtl = sDt[l];
            const int lp = rot64((l & ~15) + perm16(l & 15), ccx * 8);
            bf16_t* d = sXT + (ccx * 8) * 72 + lp;
            d[0 * 72] = f2bf(bf_lo(rw.x) * dtl); d[1 * 72] = f2bf(bf_hi(rw.x) * dtl); d[2 * 72] = f2bf(bf_lo(rw.y) * dtl); d[3 * 72] = f2bf(bf_hi(rw.y) * dtl);
            d[4 * 72] = f2bf(bf_lo(rw.z) * dtl); d[5 * 72] = f2bf(bf_hi(rw.z) * dtl); d[6 * 72] = f2bf(bf_lo(rw.w) * dtl); d[7 * 72] = f2bf(bf_hi(rw.w) * dtl);
        }
        u32x2 zc[4];
#pragma unroll
        for (int gq = 0; gq < 4; ++gq) zc[gq] = zr[gq];
        __syncthreads();
        if (c + 1 < 64) SSD_PREFETCH(c + 1);
        const float acl = sAc[lq];
        f32x16 y = zero16();
#pragma unroll
        for (int ks = 0; ks < 8; ++ks) {
            const bf16x8 fa = *(const bf16x8*)(sH + (ph * 32 + r) * 136 + ks * 16 + 8 * h5);
            const bf16x8 fb = *(const bf16x8*)(sC + lq * 136 + ks * 16 + 8 * h5);
            y = mfma32(fa, fb, y);
        }
        {
            const float el = __expf(acl);
#pragma unroll
            for (int i = 0; i < 16; ++i) y[i] *= el;
        }
        for (int st = 0; st <= lt; ++st) {
            f32x16 x = zero16();
#pragma unroll
            for (int ks = 0; ks < 8; ++ks) {
                const bf16x8 fa = *(const bf16x8*)(sB + (st * 32 + r) * 136 + ks * 16 + 8 * h5);
                const bf16x8 fb = *(const bf16x8*)(sC + lq * 136 + ks * 16 + 8 * h5);
                x = mfma32(fa, fb, x);
            }
#pragma unroll
            for (int i = 0; i < 16; ++i) {
                const int s_ = st * 32 + 8 * (i >> 2) + 4 * h5 + (i & 3);
                const float sg = (s_ <= lq) ? __expf(acl - sAc[s_]) : 0.f;
                x[i] *= sg;
            }
#pragma unroll
            for (int s2 = 0; s2 < 2; ++s2) {
                union { bf16x8 v; unsigned u[4]; } cv;
#pragma unroll
                for (int j = 0; j < 4; ++j) cv.u[j] = pk_bf16(x[8 * s2 + 2 * j], x[8 * s2 + 2 * j + 1]);
                const int prow = ph * 32 + r;
                const bf16x8 fa = *(const bf16x8*)(sXT + prow * 72 + rot64(st * 32 + s2 * 16 + 8 * h5, prow));
                y = mfma32(fa, cv.v, y);
            }
        }
        {
            const size_t tk = tok0 + lq;
            const float dinv = dsk * __builtin_amdgcn_rcpf(sDt[lq]);
            const int lp = (lq & ~15) + perm16(lq & 15);
            float ss = 0.f;
#pragma unroll
            for (int gq = 0; gq < 4; ++gq) {
                const int p0 = ph * 32 + 8 * gq + 4 * h5;
                const int lpr = rot64(lp, p0);
                const float z0 = bf_lo(zc[gq].x), z1 = bf_hi(zc[gq].x), z2 = bf_lo(zc[gq].y), z3 = bf_hi(zc[gq].y);
                const float v0 = (y[4 * gq] + bf2f(sXT[(p0 + 0) * 72 + lpr]) * dinv) * siluf_(z0);
                const float v1 = (y[4 * gq + 1] + bf2f(sXT[(p0 + 1) * 72 + lpr]) * dinv) * siluf_(z1);
                const float v2 = (y[4 * gq + 2] + bf2f(sXT[(p0 + 2) * 72 + lpr]) * dinv) * siluf_(z2);
                const float v3 = (y[4 * gq + 3] + bf2f(sXT[(p0 + 3) * 72 + lpr]) * dinv) * siluf_(z3);
                ss += v0 * v0 + v1 * v1 + v2 * v2 + v3 * v3;
                *(u32x2*)(Am + tk * 1024 + 512 + hd * 64 + p0) = (u32x2){pk_bf16(v0, v1), pk_bf16(v2, v3)};
            }
            ss += xor32f(ss);
            if (h5 == 0) sss[tk * 16 + hd * 2 + ph] = ss;
        }
        {
            f32x16 hn[2] = {zero16(), zero16()};
#pragma unroll
            for (int ks = 0; ks < 4; ++ks) {
                const int nrow = w * 32 + r;
                const bf16x8 fa = *(const bf16x8*)(sBT + nrow * 72 + rot64(ks * 16 + 8 * h5, nrow));
#pragma unroll
                for (int pt = 0; pt < 2; ++pt) {
                    const int prow = pt * 32 + r;
                    const bf16x8 fb = *(const bf16x8*)(sXT + prow * 72 + rot64(ks * 16 + 8 * h5, prow));
                    hn[pt] = mfma32(fa, fb, hn[pt]);
                }
            }
            const float et = __expf(atot);
#pragma unroll
            for (int pt = 0; pt < 2; ++pt)
#pragma unroll
                for (int i = 0; i < 16; ++i) hacc[pt][i] = hacc[pt][i] * et + hn[pt][i];
        }
        __syncthreads();
#pragma unroll
        for (int pt = 0; pt < 2; ++pt)
#pragma unroll
            for (int gq = 0; gq < 4; ++gq) {
                const int n0 = w * 32 + 8 * gq + 4 * h5;
                *(u32x2*)(sH + (pt * 32 + r) * 136 + n0) = (u32x2){pk_bf16(hacc[pt][4 * gq], hacc[pt][4 * gq + 1]), pk_bf16(hacc[pt][4 * gq + 2], hacc[pt][4 * gq + 3])};
            }
    }
#undef SSD_PREFETCH
    __syncthreads();
}

template <int TT> struct EpiOutProj {
    int m0, n0;
    const float* x;
    const unsigned char* xq8;
    const float* xsc;
    float* x1;
    bf16_t* x1b;
    float* ssx;
    float r01[TT], r12[TT], r2[TT];
    DEVFI void init(unsigned char* ws, int wm, int lane) {
        const float* ssn = (const float*)(ws + WS_SSN);
        const float* sss = (const float*)(ws + WS_SSS);
#pragma unroll
        for (int tt = 0; tt < TT; ++tt) {
            const size_t tok = (size_t)m0 + wm * 32 * TT + tt * 32 + (lane & 31);
            const f32x4 a0 = *(const f32x4*)(ssn + tok * 8), a1 = *(const f32x4*)(ssn + tok * 8 + 4);
            const float s0 = (a0.x + a0.y + a0.z + a0.w) + (a1.x + a1.y + a1.z + a1.w);
            const f32x4 b0 = *(const f32x4*)(sss + tok * 16), b1 = *(const f32x4*)(sss + tok * 16 + 4);
            const f32x4 b2 = *(const f32x4*)(sss + tok * 16 + 8), b3 = *(const f32x4*)(sss + tok * 16 + 12);
            const float s1 = (b0.x + b0.y + b0.z + b0.w) + (b1.x + b1.y + b1.z + b1.w);
            const float s2 = (b2.x + b2.y + b2.z + b2.w) + (b3.x + b3.y + b3.z + b3.w);
            const float q0 = rsqrtf(s0 * (1.f / 512.f) + EPS), q1 = rsqrtf(s1 * (1.f / 256.f) + EPS), q2 = rsqrtf(s2 * (1.f / 256.f) + EPS);
            r01[tt] = q0 / q1; r12[tt] = q1 / q2; r2[tt] = q2;
        }
    }
    DEVFI void hook(int kt, f32x16 (&acc)[2][TT]) const {
        if (kt == 7 || kt == 11) {
#pragma unroll
            for (int tt = 0; tt < TT; ++tt) {
                const float f = (kt == 7) ? r01[tt] : r12[tt];
#pragma unroll
                for (int ft = 0; ft < 2; ++ft)
#pragma unroll
                    for (int i = 0; i < 16; ++i) acc[ft][tt][i] *= f;
            }
        }
    }
    unsigned char* stage;
    unsigned char* x8;
    float* sx;
    DEVFI void operator()(f32x16 (&acc)[2][TT], int wm, int wn, int lane) const {
        const int h5 = lane >> 5, r = lane & 31;
        float* st = (float*)stage + (wm * 2 + wn) * (32 * 68);
        const int rrow = lane >> 4, c4 = (lane & 15) * 4;
        const int n = n0 + wn * 64 + c4;
        unsigned xv[8], xn_[8]; float xs[8], xsn_[8];
#pragma unroll
        for (int i = 0; i < 8; ++i) { const size_t t_ = (size_t)m0 + wm * 32 * TT + i * 4 + rrow; xv[i] = *(const unsigned*)(xq8 + t_ * 1024 + n); xs[i] = xsc[t_]; }
#pragma unroll
        for (int tt = 0; tt < TT; ++tt) {
            if (tt + 1 < TT) {
#pragma unroll
                for (int i = 0; i < 8; ++i) { const size_t t_ = (size_t)m0 + wm * 32 * TT + (tt + 1) * 32 + i * 4 + rrow; xn_[i] = *(const unsigned*)(xq8 + t_ * 1024 + n); xsn_[i] = xsc[t_]; }
            }
#pragma unroll
            for (int ft = 0; ft < 2; ++ft)
#pragma unroll
                for (int gq = 0; gq < 4; ++gq) {
                    f32x4 v;
#pragma unroll
                    for (int e = 0; e < 4; ++e) v[e] = acc[ft][tt][4 * gq + e] * r2[tt];
                    *(f32x4*)(st + r * 68 + ft * 32 + 8 * gq + 4 * h5) = v;
                }
            float ssk = 0.f, amk = 0.f;
#pragma unroll
            for (int i = 0; i < 8; ++i) {
                const int row = i * 4 + rrow;
                const size_t tok = (size_t)m0 + wm * 32 * TT + tt * 32 + row;
                const f32x4 a = *(const f32x4*)(st + row * 68 + c4);
                const f32x4 y = (f32x4){a.x + (float)(signed char)(xv[i] & 255u) * xs[i], a.y + (float)(signed char)((xv[i] >> 8) & 255u) * xs[i],
                                        a.z + (float)(signed char)((xv[i] >> 16) & 255u) * xs[i], a.w + (float)(signed char)(xv[i] >> 24) * xs[i]};
                *(u32x2*)(x1b + tok * 1024 + n) = (u32x2){pk_bf16(y.x, y.y), pk_bf16(y.z, y.w)};
                const float ss = row16_sum((y.x * y.x + y.y * y.y) + (y.z * y.z + y.w * y.w));
                const float am = row16_max(fmaxf(fmaxf(fabsf(y.x), fabsf(y.y)), fmaxf(fabsf(y.z), fabsf(y.w))));
                const float qs = am > 0.f ? 7.f * __builtin_amdgcn_rcpf(am) : 0.f;
                const int q0 = (int)rintf(y.x * qs), q1 = (int)rintf(y.y * qs), q2 = (int)rintf(y.z * qs), q3 = (int)rintf(y.w * qs);
                *(unsigned short*)(x8 + tok * 512 + (n >> 1)) = (unsigned short)(((unsigned)q0 & 15u) | (((unsigned)q1 & 15u) << 4) | (((unsigned)q2 & 15u) << 8) | (((unsigned)q3 & 15u) << 12));
                if ((lane & 15) == i) { ssk = ss; amk = am; }
            }
            if ((lane & 15) < 8) {
                const size_t tok = (size_t)m0 + wm * 32 * TT + tt * 32 + (lane & 15) * 4 + rrow;
                ssx[tok * 16 + (n0 >> 7) * 2 + wn] = ssk; sx[tok * 16 + (n0 >> 7) * 2 + wn] = amk * (1.f / 7.f);
            }
            if (tt + 1 < TT) {
#pragma unroll
                for (int i = 0; i < 8; ++i) { xv[i] = xn_[i]; xs[i] = xsn_[i]; }
            }
        }
    }
};

DEVFI void copy_x1(const Params& P_) {
    size_t zoff_ = 0; asm volatile("" : "+s"(zoff_)); const Params& P = *(const Params*)((const char*)&P_ + zoff_);
    const int bid = blockIdx.x, nb = gridDim.x, tid = threadIdx.x, lane = tid & 63, w = tid >> 6;
    const float* x = P.in[0];
    bf16_t* x1b = (bf16_t*)(P.ws + WS_X1B);
    float* ssx = (float*)(P.ws + WS_SSX);
    for (int row = bid * 4 + w; row < T; row += nb * 4) {
        const f32x4* xr = (const f32x4*)(x + (size_t)row * D) + lane;
        f32x4* o1 = (f32x4*)(P.out + (size_t)row * D) + lane;
        u32x2* o2 = (u32x2*)(x1b + (size_t)row * D) + lane;
        float ss = 0.f;
#pragma unroll
        for (int j = 0; j < 4; ++j) {
            const f32x4 v = xr[64 * j];
            ss += v.x * v.x + v.y * v.y + v.z * v.z + v.w * v.w;
            o1[64 * j] = v;
            o2[64 * j] = (u32x2){pk_bf16(v.x, v.y), pk_bf16(v.z, v.w)};
        }
        ss = wave_sum(ss);
        if (lane < 16) ssx[(size_t)row * 16 + lane] = lane == 0 ? ss : 0.f;
    }
}

DEVFI float fmax_raw(float a, float b) { float r; asm("v_max_f32 %0, %1, %2" : "=v"(r) : "v"(a), "v"(b)); return r; }
DEVFI float fmin_raw(float a, float b) { float r; asm("v_min_f32 %0, %1, %2" : "=v"(r) : "v"(a), "v"(b)); return r; }
#define CE_DESC(x_, y_) do { const float mx_ = fmax_raw(x_, y_), mn_ = fmin_raw(x_, y_); x_ = mx_; y_ = mn_; } while (0)
__host__ __device__ constexpr int s16A(int i) {
    constexpr signed char t[60] = {0,1,2,3,4,5,7,9,0,1,2,3,6,8,10,11,0,2,4,6,7,10,12,14,0,1,4,5,6,8,12,13,1,3,4,5,8,9,13,1,2,5,7,9,11,2,3,9,11,3,6,7,10,3,5,7,9,11,6,8};
    return t[i];
}
__host__ __device__ constexpr int s16B(int i) {
    constexpr signed char t[60] = {13,12,15,14,8,6,11,10,5,7,9,4,13,14,15,12,1,3,5,8,9,11,13,15,2,3,10,11,7,9,14,15,2,12,6,7,10,11,14,4,6,8,10,13,14,4,6,12,13,5,8,9,12,4,6,8,10,12,7,9};
    return t[i];
}
template <int C> DEVFI void s16_step(float (&k)[16]) { constexpr int a = s16A(C), b = s16B(C); CE_DESC(k[a], k[b]); }
template <int... Cs> DEVFI void s16_run(float (&k)[16], std::integer_sequence<int, Cs...>) { (s16_step<Cs>(k), ...); }
DEVFI void sort16_desc(float (&k)[16]) { s16_run(k, std::make_integer_sequence<int, 60>{}); }
DEVFI void bitonic_merge16_desc(float (&c)[16]) {
#pragma unroll
    for (int st = 8; st > 0; st >>= 1)
#pragma unroll
        for (int i = 0; i < 16; ++i) {
            const int j = i ^ st;
            if (j > i) CE_DESC(c[i], c[j]);
        }
}
DEVFI void merge16_inlane(float (&run)[16], const float (&oth)[16]) {
    float c[16];
#pragma unroll
    for (int i = 0; i < 16; ++i) c[i] = fmax_raw(run[i], oth[15 - i]);
    bitonic_merge16_desc(c);
#pragma unroll
    for (int i = 0; i < 16; ++i) run[i] = c[i];
}
DEVFI void merge16_x32(float (&k)[16]) {
    float lo[16], hi[16];
#pragma unroll
    for (int i = 0; i < 16; ++i) {
#if __has_builtin(__builtin_amdgcn_permlane32_swap)
        const unsigned u = __float_as_uint(k[i]);
        const auto pr = __builtin_amdgcn_permlane32_swap(u, u, false, false);
        lo[i] = __uint_as_float(pr[0]); hi[i] = __uint_as_float(pr[1]);
#else
        const float o = __shfl_xor(k[i], 32);
        lo[i] = (threadIdx.x & 32) ? o : k[i]; hi[i] = (threadIdx.x & 32) ? k[i] : o;
#endif
    }
    float c[16];
#pragma unroll
    for (int i = 0; i < 16; ++i) c[i] = fmax_raw(lo[i], hi[15 - i]);
    bitonic_merge16_desc(c);
#pragma unroll
    for (int i = 0; i < 16; ++i) k[i] = c[i];
}
struct EpiRoute {
    float top[2][16];
    DEVFI void hook(int, f32x16 (&)[4][2]) const {}
    DEVFI void operator()(f32x16 (&acc)[4][2], int wm, int wn, int lane) {
        const unsigned hb = (lane & 32) ? 0u : 4u;
#pragma unroll
        for (int tt = 0; tt < 2; ++tt) {
#pragma unroll
            for (int ft = 0; ft < 4; ++ft) {
                float k16[16];
#pragma unroll
                for (int i = 0; i < 16; ++i) {
                    const unsigned cb = (~(unsigned)(ft * 32 + 8 * (i >> 2) + (i & 3))) & 0x7Bu;
                    k16[i] = __uint_as_float((__float_as_uint(acc[ft][tt][i]) & ~0x7Fu) | hb | cb);
                }
                sort16_desc(k16);
                if (ft == 0) {
#pragma unroll
                    for (int i = 0; i < 16; ++i) top[tt][i] = k16[i];
                } else merge16_inlane(top[tt], k16);
            }
            merge16_x32(top[tt]);
        }
    }
};
__host__ __device__ constexpr int cellA(int i) {
    constexpr signed char t[64] = {0,0,0,0,0,0,0,0,0,0,0,0,0,0,0,0, 1,1,1,1,1,1,1,1,2,2,2,2,2,3,3,3, 3,4,4,4,5,5,6,6,7,7,8,9,10,11,12,13, 14,15,-1,-1,-1,-1,-1,-1,-1,-1,-1,-1,-1,-1,-1,-1};
    return t[i];
}
__host__ __device__ constexpr int cellB(int i) {
    constexpr signed char t[64] = {0,1,2,3,4,5,6,7,8,9,10,11,12,13,14,15, 0,1,2,3,4,5,6,7,0,1,2,3,4,0,1,2, 3,0,1,2,0,1,0,1,0,1,0,0,0,0,0,0, 0,0,0,0,0,0,0,0,0,0,0,0,0,0,0,0};
    return t[i];
}
template <int GI>
DEVFI void cand_group(const float (&v1)[16], const float (&v2)[16], float (&ck)[16]) {
#define CG_(e) { constexpr int ca = cellA(GI * 16 + (e)), cb = cellB(GI * 16 + (e)); \
        if constexpr (ca >= 0) ck[e] = __uint_as_float((__float_as_uint(v1[ca] + v2[cb]) & ~0xFFu) | (unsigned)(255 - (ca * 16 + cb))); \
        else ck[e] = -__builtin_inff(); }
    CG_(0) CG_(1) CG_(2) CG_(3) CG_(4) CG_(5) CG_(6) CG_(7) CG_(8) CG_(9) CG_(10) CG_(11) CG_(12) CG_(13) CG_(14) CG_(15)
#undef CG_
}

DEVFI void peer_route_item(const Params& P_, int item, unsigned char* smem, const int rot_, const int nk_ = 16) {
    size_t zoff_ = 0; asm volatile("" : "+s"(zoff_)); const Params& P = *(const Params*)((const char*)&P_ + zoff_); unsigned char* ws = P.ws + zoff_;
    int tid = threadIdx.x; asm volatile("" : "+v"(tid));
    const int lane = tid & 63, wid = __builtin_amdgcn_readfirstlane(tid >> 6), h5 = lane >> 5;
    const int wm = wid >> 1, wn = wid & 1;
    const int mt = item >> 3, hh = item & 7;
    const size_t tok = (size_t)mt * 128 + wm * 64 + wn * 32 + (lane & 31);
    EpiRoute er;
    gemm_tile3_i8<4, 2>(ws + WS_X8T + (size_t)mt * 128 * 1024, 1024, ws + WS_WQ8 + (size_t)(hh * 2) * 128 * 1024, 1024, nk_,
                        (const float*)(ws + WS_QF) + mt * 128, (const float*)(ws + WS_SWQ) + hh * 256, smem, er);
    float* xl = (float*)smem;
    if (h5 == 0) {
#pragma unroll
        for (int i = 0; i < 16; ++i) xl[((wid * 2 + (1 - wn)) * 16 + i) * 32 + lane] = wn ? er.top[0][i] : er.top[1][i];
    }
    __syncthreads();
    float t0[16], t1[16];
#pragma unroll
    for (int i = 0; i < 16; ++i) {
        const float own = wn ? er.top[1][i] : er.top[0][i];
        const float oth = xl[(((wm * 2 + (1 - wn)) * 2 + wn) * 16 + i) * 32 + (lane & 31)];
        t0[i] = wn ? oth : own; t1[i] = wn ? own : oth;
    }
    __syncthreads();
    float v1[16], v2[16];
#pragma unroll
    for (int i = 0; i < 16; ++i) { v1[i] = __uint_as_float(__float_as_uint(t0[i]) & ~0x7Fu); v2[i] = __uint_as_float(__float_as_uint(t1[i]) & ~0x7Fu); }
    float run[16];
    {
        float ck[16];
        cand_group<0>(v1, v2, run); sort16_desc(run);
        cand_group<1>(v1, v2, ck); sort16_desc(ck); merge16_inlane(run, ck);
        cand_group<2>(v1, v2, ck); sort16_desc(ck); merge16_inlane(run, ck);
        cand_group<3>(v1, v2, ck); sort16_desc(ck); merge16_inlane(run, ck);
    }
    unsigned char* tab = smem + 65536 + wid * 1024 + (lane & 31) * 32;
    {
        unsigned pa[4], pb[4];
#pragma unroll
        for (int q = 0; q < 4; ++q) {
            unsigned wa = 0u, wb = 0u;
#pragma unroll
            for (int e = 0; e < 4; ++e) { wa |= (127u - (__float_as_uint(t0[4 * q + e]) & 0x7Fu)) << (8 * e); wb |= (127u - (__float_as_uint(t1[4 * q + e]) & 0x7Fu)) << (8 * e); }
            pa[q] = wa; pb[q] = wb;
        }
        if (h5 == 0) *(u32x4*)tab = (u32x4){pa[0], pa[1], pa[2], pa[3]};
        else *(u32x4*)(tab + 16) = (u32x4){pb[0], pb[1], pb[2], pb[3]};
    }
    float val[16]; int eidx[16];
    const float vmax = __uint_as_float(__float_as_uint(run[0]) & ~0xFFu);
    float sum = 0.f;
#pragma unroll
    for (int j = 0; j < 16; ++j) {
        const int flat = 255 - (int)(__float_as_uint(run[j]) & 0xFFu);
        const int ca = flat >> 4, cb = flat & 15;
        eidx[j] = (int)tab[ca] * 128 + (int)tab[16 + cb];
        val[j] = __expf(__uint_as_float(__float_as_uint(run[j]) & ~0xFFu) - vmax);
        sum += val[j];
    }
    const float inv = 1.f / sum;
    unsigned short* oi = (unsigned short*)(ws + WS_IDX) + tok * 128 + hh * 16 + h5 * 8;
    float* og = (float*)(ws + WS_GATE) + tok * 128 + hh * 16 + h5 * 8;
    if (h5 == 0) {
        *(u32x4*)oi = (u32x4){(unsigned)eidx[0] | ((unsigned)eidx[1] << 16), (unsigned)eidx[2] | ((unsigned)eidx[3] << 16),
                              (unsigned)eidx[4] | ((unsigned)eidx[5] << 16), (unsigned)eidx[6] | ((unsigned)eidx[7] << 16)};
        *(f32x4*)og = (f32x4){val[0] * inv, val[1] * inv, val[2] * inv, val[3] * inv};
        *(f32x4*)(og + 4) = (f32x4){val[4] * inv, val[5] * inv, val[6] * inv, val[7] * inv};
    } else {
        *(u32x4*)oi = (u32x4){(unsigned)eidx[8] | ((unsigned)eidx[9] << 16), (unsigned)eidx[10] | ((unsigned)eidx[11] << 16),
                              (unsigned)eidx[12] | ((unsigned)eidx[13] << 16), (unsigned)eidx[14] | ((unsigned)eidx[15] << 16)};
        *(f32x4*)og = (f32x4){val[8] * inv, val[9] * inv, val[10] * inv, val[11] * inv};
        *(f32x4*)(og + 4) = (f32x4){val[12] * inv, val[13] * inv, val[14] * inv, val[15] * inv};
    }
}

constexpr size_t WS_C = WS_XN;
constexpr size_t WS_PART = WS_XBC;
constexpr size_t WS_YB = WS_AMAT;
DEVFI void peer_u_task(unsigned char* ws, size_t tok0, int q, int lane, int* wl  ) {
    const int ts = lane >> 3, ch = lane & 7;
    const size_t tok = tok0 + ts;
    const int b0 = lane & 1, b1 = (lane >> 1) & 1, b2 = (lane >> 2) & 1;
    const int sl = q & 3;
    const u32x4 xq = *(const u32x4*)(ws + WS_X8 + tok * 512 + sl * 128 + ch * 16);
    const float sxl = ((const float*)(ws + WS_SX))[tok * 16 + sl * 4 + (ch >> 1)];
    const unsigned short* ip = (const unsigned short*)(ws + WS_IDX) + tok * 128;
    const unsigned char* ub = ws + WS_U + (size_t)sl * (16384 * 128) + ch * 16;
    unsigned* pp = (unsigned*)(ws + WS_PART) + ((size_t)sl * T + tok) * 64;
    {
#pragma unroll
        for (int k = 0; k < 2; ++k) {
            const u32x4 v_ = *(const u32x4*)(ip + ch * 16 + 8 * k);
            *(u32x4*)(wl + lane * 16 + 8 * k) = (u32x4){v_.x & 0xFFFFu, v_.x >> 16, v_.y & 0xFFFFu, v_.y >> 16};
            *(u32x4*)(wl + lane * 16 + 8 * k + 4) = (u32x4){v_.z & 0xFFFFu, v_.z >> 16, v_.w & 0xFFFFu, v_.w >> 16};
        }
    }
    const int* lid = wl + ts * 128;
    u32x4 ua[8], ubuf[8];
#define PU_ISSUE(dst, hs_) do { const u32x4 e0_ = *(const u32x4*)(lid + (hs_) * 8), e1_ = *(const u32x4*)(lid + (hs_) * 8 + 4); \
        dst[0] = *(const u32x4*)(ub + (size_t)e0_.x * 128); dst[1] = *(const u32x4*)(ub + (size_t)e0_.y * 128); \
        dst[2] = *(const u32x4*)(ub + (size_t)e0_.z * 128); dst[3] = *(const u32x4*)(ub + (size_t)e0_.w * 128); \
        dst[4] = *(const u32x4*)(ub + (size_t)e1_.x * 128); dst[5] = *(const u32x4*)(ub + (size_t)e1_.y * 128); \
        dst[6] = *(const u32x4*)(ub + (size_t)e1_.z * 128); dst[7] = *(const u32x4*)(ub + (size_t)e1_.w * 128); } while (0)
#define PU_DOT(src, dd, off) do { _Pragma("unroll") for (int p = 0; p < 8; ++p) { \
        int is_ = __builtin_amdgcn_sdot8((int)src[p][0], (int)xq.x, 0, false); \
        is_ = __builtin_amdgcn_sdot8((int)src[p][1], (int)xq.y, is_, false); \
        is_ = __builtin_amdgcn_sdot8((int)src[p][2], (int)xq.z, is_, false); \
        is_ = __builtin_amdgcn_sdot8((int)src[p][3], (int)xq.w, is_, false); \
        dd[(off) + p] = (float)is_ * sxl; } } while (0)
    PU_ISSUE(ua, 0);
#pragma unroll 1
    for (int blk = 0; blk < 8; ++blk) {
        float d[16];
        PU_ISSUE(ubuf, 2 * blk + 1);
        PU_DOT(ua, d, 0);
        if (blk < 7) PU_ISSUE(ua, 2 * blk + 2);
        PU_DOT(ubuf, d, 8);
        float d8[8], d4[4], d2[2];
#pragma unroll
        for (int i = 0; i < 8; ++i) { const float keep = b2 ? d[i + 8] : d[i], send = b2 ? d[i] : d[i + 8]; d8[i] = keep + xor4f(send); }
#pragma unroll
        for (int i = 0; i < 4; ++i) { const float keep = b1 ? d8[i + 4] : d8[i], send = b1 ? d8[i] : d8[i + 4]; d4[i] = keep + xor2f(send); }
#pragma unroll
        for (int i = 0; i < 2; ++i) { const float keep = b0 ? d4[i + 2] : d4[i], send = b0 ? d4[i] : d4[i + 2]; d2[i] = keep + xor1f(send); }
        pp[blk * 8 + 4 * b2 + 2 * b1 + b0] = pk_bf16(d2[0], d2[1]);
    }
#undef PU_ISSUE
#undef PU_DOT
}
DEVFI void peer_c_tokens4(unsigned char* ws, size_t tok0, int lane) {
    const float* SU = (const float*)(ws + WS_SU);
    const float* SV = (const float*)(ws + WS_SV);
    unsigned ids[4]; f32x2 gt[4]; unsigned pv[4][4]; f32x4 sq4[4];
#pragma unroll
    for (int t = 0; t < 4; ++t) {
        const size_t tok = tok0 + t;
        ids[t] = *((const unsigned*)(ws + WS_IDX) + tok * 64 + lane);
        gt[t] = *(const f32x2*)((const float*)(ws + WS_GATE) + tok * 128 + 2 * lane);
        const unsigned* pp = (const unsigned*)(ws + WS_PART) + tok * 64 + lane;
#pragma unroll
        for (int q = 0; q < 4; ++q) pv[t][q] = pp[(size_t)q * T * 64];
        sq4[t] = *(const f32x4*)((const float*)(ws + WS_SSX) + tok * 16 + (lane & 3) * 4);
    }
    float su0[4], su1[4], sv0[4], sv1[4];
#pragma unroll
    for (int t = 0; t < 4; ++t) {
        const int e0 = (int)(ids[t] & 0xFFFFu), e1 = (int)(ids[t] >> 16);
        su0[t] = SU[e0]; su1[t] = SU[e1]; sv0[t] = SV[e0]; sv1[t] = SV[e1];
    }
#pragma unroll
    for (int t = 0; t < 4; ++t) {
        float sq = (sq4[t].x + sq4[t].y) + (sq4[t].z + sq4[t].w);
        sq += xor1f(sq); sq += xor2f(sq);
        const float rs = rsqrtf(sq * (1.f / 1024.f) + EPS);
        float d0 = 0.f, d1 = 0.f;
#pragma unroll
        for (int q = 0; q < 4; ++q) { d0 += bf_lo(pv[t][q]); d1 += bf_hi(pv[t][q]); }
        *((unsigned*)(ws + WS_C) + (tok0 + t) * 64 + lane) = pk_bf16(gt[t].x * sv0[t] * gelu_tanh(d0 * rs * su0[t]), gt[t].y * sv1[t] * gelu_tanh(d1 * rs * su1[t]));
    }
}
typedef _Float16 h2v __attribute__((ext_vector_type(2)));
DEVFI void peer_v_task(const Params& P, unsigned char* ws, size_t tok0, int q, int lane, const bool dry, int* wl  ) {
    const int ts = lane >> 3, ch = lane & 7;
    const size_t tok = tok0 + ts;
    const unsigned short* ip = (const unsigned short*)(ws + WS_IDX) + tok * 128;
    const bf16_t* cp = (const bf16_t*)(ws + WS_C) + tok * 128;
    const int sl = q & 3;
    const unsigned char* vb = ws + WS_V + (size_t)sl * (16384 * 128) + ch * 16;
    h2v acc[16];
#pragma unroll
    for (int j = 0; j < 16; ++j) acc[j] = (h2v){(_Float16)0, (_Float16)0};
    {
#pragma unroll
        for (int k = 0; k < 2; ++k) {
            const u32x4 v_ = *(const u32x4*)(ip + ch * 16 + 8 * k);
            *(u32x4*)(wl + lane * 16 + 8 * k) = (u32x4){v_.x & 0xFFFFu, v_.x >> 16, v_.y & 0xFFFFu, v_.y >> 16};
            *(u32x4*)(wl + lane * 16 + 8 * k + 4) = (u32x4){v_.z & 0xFFFFu, v_.z >> 16, v_.w & 0xFFFFu, v_.w >> 16};
        }
#pragma unroll
        for (int k = 0; k < 2; ++k) {
            const u32x4 c_ = *(const u32x4*)(cp + ch * 16 + 8 * k);
            *(f32x4*)((float*)wl + 1024 + lane * 16 + 8 * k) = (f32x4){bf_lo(c_.x), bf_hi(c_.x), bf_lo(c_.y), bf_hi(c_.y)};
            *(f32x4*)((float*)wl + 1024 + lane * 16 + 8 * k + 4) = (f32x4){bf_lo(c_.z), bf_hi(c_.z), bf_lo(c_.w), bf_hi(c_.w)};
        }
    }
    const int* lid = wl + ts * 128;
    const float* lcf = (const float*)wl + 1024 + ts * 128;
    u32x4 va[8], vbuf[8];
#define PV_ISSUE(dst, hs_) do { const u32x4 e0_ = *(const u32x4*)(lid + (hs_) * 8), e1_ = *(const u32x4*)(lid + (hs_) * 8 + 4); \
        dst[0] = *(const u32x4*)(vb + (size_t)e0_.x * 128); dst[1] = *(const u32x4*)(vb + (size_t)e0_.y * 128); \
        dst[2] = *(const u32x4*)(vb + (size_t)e0_.z * 128); dst[3] = *(const u32x4*)(vb + (size_t)e0_.w * 128); \
        dst[4] = *(const u32x4*)(vb + (size_t)e1_.x * 128); dst[5] = *(const u32x4*)(vb + (size_t)e1_.y * 128); \
        dst[6] = *(const u32x4*)(vb + (size_t)e1_.z * 128); dst[7] = *(const u32x4*)(vb + (size_t)e1_.w * 128); } while (0)
#define PV_FMA(src, hs_) do { const f32x4 c0_ = *(const f32x4*)(lcf + (hs_) * 8), c1_ = *(const f32x4*)(lcf + (hs_) * 8 + 4); \
        _Pragma("unroll") for (int p = 0; p < 8; ++p) { const float c_ = (p < 4) ? c0_[p & 3] : c1_[p & 3]; \
        const h2v c2 = __builtin_bit_cast(h2v, __builtin_amdgcn_cvt_pkrtz(c_, c_)); \
        _Pragma("unroll") for (int k = 0; k < 4; ++k) { \
            acc[4 * k] = __builtin_amdgcn_cvt_scalef32_pk_f16_fp4(src[p][k], 1.0f, 0) * c2 + acc[4 * k]; \
            acc[4 * k + 1] = __builtin_amdgcn_cvt_scalef32_pk_f16_fp4(src[p][k], 1.0f, 1) * c2 + acc[4 * k + 1]; \
            acc[4 * k + 2] = __builtin_amdgcn_cvt_scalef32_pk_f16_fp4(src[p][k], 1.0f, 2) * c2 + acc[4 * k + 2]; \
            acc[4 * k + 3] = __builtin_amdgcn_cvt_scalef32_pk_f16_fp4(src[p][k], 1.0f, 3) * c2 + acc[4 * k + 3]; } } } while (0)
    PV_ISSUE(va, 0);
#pragma unroll 1
    for (int hs = 0; hs < 16; hs += 2) {
        PV_ISSUE(vbuf, hs + 1);
        PV_FMA(va, hs);
        if (hs < 14) PV_ISSUE(va, hs + 2);
        PV_FMA(vbuf, hs + 1);
    }
#undef PV_ISSUE
#undef PV_FMA
    const bf16_t* xrow = (const bf16_t*)(ws + WS_X1B) + tok * 1024 + sl * 256 + ch * 32;
    bf16_t* yrow = (bf16_t*)(ws + (dry ? WS_Q : WS_YB)) + (dry ? (tok & 8191) : tok) * 1024 + sl * 256 + ch * 32;
    u32x4 xv[4];
#pragma unroll
    for (int j = 0; j < 4; ++j) xv[j] = *(const u32x4*)(xrow + 8 * j);
#pragma unroll
    for (int j = 0; j < 4; ++j)
        *(u32x4*)(yrow + 8 * j) = (u32x4){pk_bf16(bf_lo(xv[j].x) + (float)acc[4 * j].x, bf_hi(xv[j].x) + (float)acc[4 * j].y), pk_bf16(bf_lo(xv[j].y) + (float)acc[4 * j + 1].x, bf_hi(xv[j].y) + (float)acc[4 * j + 1].y),
                                  pk_bf16(bf_lo(xv[j].z) + (float)acc[4 * j + 2].x, bf_hi(xv[j].z) + (float)acc[4 * j + 2].y), pk_bf16(bf_lo(xv[j].w) + (float)acc[4 * j + 3].x, bf_hi(xv[j].w) + (float)acc[4 * j + 3].y)};
}
DEVFI void final_norm_tokens4(const Params& P, size_t tok0, int lane) {
    const float* fg = P.in[24] + lane * 16;
    u32x4 a[4], b[4];
#pragma unroll
    for (int t = 0; t < 4; ++t) {
        const bf16_t* yb = (const bf16_t*)(P.ws + WS_YB) + (tok0 + t) * 1024 + lane * 16;
        a[t] = *(const u32x4*)yb; b[t] = *(const u32x4*)(yb + 8);
    }
    f32x4 gk[4];
#pragma unroll
    for (int k = 0; k < 4; ++k) gk[k] = *(const f32x4*)(fg + 4 * k);
#pragma unroll
    for (int t = 0; t < 4; ++t) {
        float* orow = P.out + (tok0 + t) * 1024 + lane * 16;
        f32x4 y[4] = {(f32x4){bf_lo(a[t].x), bf_hi(a[t].x), bf_lo(a[t].y), bf_hi(a[t].y)}, (f32x4){bf_lo(a[t].z), bf_hi(a[t].z), bf_lo(a[t].w), bf_hi(a[t].w)},
                      (f32x4){bf_lo(b[t].x), bf_hi(b[t].x), bf_lo(b[t].y), bf_hi(b[t].y)}, (f32x4){bf_lo(b[t].z), bf_hi(b[t].z), bf_lo(b[t].w), bf_hi(b[t].w)}};
        float ss = 0.f;
#pragma unroll
        for (int k = 0; k < 4; ++k) ss += y[k].x * y[k].x + y[k].y * y[k].y + y[k].z * y[k].z + y[k].w * y[k].w;
        ss = wave_sum(ss);
        const float rf = rsqrtf(ss * (1.f / 1024.f) + EPS);
#pragma unroll
        for (int k = 0; k < 4; ++k)
            *(f32x4*)(orow + 4 * k) = (f32x4){y[k].x * rf * gk[k].x, y[k].y * rf * gk[k].y, y[k].z * rf * gk[k].z, y[k].w * rf * gk[k].w};
    }
}

DEVFI void wq_quant_row(unsigned char* ws, int row, int lane) {
    const bf16_t* src = (const bf16_t*)(ws + WS_WQ) + (size_t)row * 1024 + lane * 16;
    const u32x4 a = *(const u32x4*)src, b = *(const u32x4*)(src + 8);
    float v[16] = {bf_lo(a.x), bf_hi(a.x), bf_lo(a.y), bf_hi(a.y), bf_lo(a.z), bf_hi(a.z), bf_lo(a.w), bf_hi(a.w),
                   bf_lo(b.x), bf_hi(b.x), bf_lo(b.y), bf_hi(b.y), bf_lo(b.z), bf_hi(b.z), bf_lo(b.w), bf_hi(b.w)};
    float am = 0.f;
#pragma unroll
    for (int j = 0; j < 16; ++j) am = fmaxf(am, fabsf(v[j]));
    am = wave_max(am);
    const float qs = am > 0.f ? 127.f / am : 0.f;
    unsigned o[4];
#pragma unroll
    for (int q = 0; q < 4; ++q) {
        const int q0 = (int)rintf(v[4 * q] * qs), q1 = (int)rintf(v[4 * q + 1] * qs), q2 = (int)rintf(v[4 * q + 2] * qs), q3 = (int)rintf(v[4 * q + 3] * qs);
        o[q] = ((unsigned)q0 & 255u) | (((unsigned)q1 & 255u) << 8) | (((unsigned)q2 & 255u) << 16) | (((unsigned)q3 & 255u) << 24);
    }
    *(u32x4*)(ws + WS_WQ8 + (size_t)row * 1024 + lane * 16) = (u32x4){o[0], o[1], o[2], o[3]};
    if (lane == 0) ((float*)(ws + WS_SWQ))[row] = am * (1.f / 127.f);
}
DEVFI void x1_requant_tokens4(unsigned char* ws, size_t tok0, int lane) {
    u32x4 a[4], b[4]; f32x4 sx4[4], ss4[4];
#pragma unroll
    for (int t = 0; t < 4; ++t) {
        const bf16_t* xr = (const bf16_t*)(ws + WS_X1B) + (tok0 + t) * 1024 + lane * 16;
        a[t] = *(const u32x4*)xr; b[t] = *(const u32x4*)(xr + 8);
        sx4[t] = *(const f32x4*)((const float*)(ws + WS_SX) + (tok0 + t) * 16 + (lane & 3) * 4);
        ss4[t] = *(const f32x4*)((const float*)(ws + WS_SSX) + (tok0 + t) * 16 + (lane & 3) * 4);
    }
#pragma unroll
    for (int t = 0; t < 4; ++t) {
        float am = fmaxf(fmaxf(sx4[t].x, sx4[t].y), fmaxf(sx4[t].z, sx4[t].w));
        am = fmaxf(am, xor1f(am)); am = fmaxf(am, xor2f(am));
        am *= 7.f;
        float sq = (ss4[t].x + ss4[t].y) + (ss4[t].z + ss4[t].w);
        sq += xor1f(sq); sq += xor2f(sq);
        const float rs = rsqrtf(sq * (1.f / 1024.f) + EPS);
        const float qs = am > 0.f ? 127.f / am : 0.f;
        const float v[16] = {bf_lo(a[t].x), bf_hi(a[t].x), bf_lo(a[t].y), bf_hi(a[t].y), bf_lo(a[t].z), bf_hi(a[t].z), bf_lo(a[t].w), bf_hi(a[t].w),
                             bf_lo(b[t].x), bf_hi(b[t].x), bf_lo(b[t].y), bf_hi(b[t].y), bf_lo(b[t].z), bf_hi(b[t].z), bf_lo(b[t].w), bf_hi(b[t].w)};
        unsigned o[4];
#pragma unroll
        for (int q = 0; q < 4; ++q) {
            const int q0 = (int)rintf(v[4 * q] * qs), q1 = (int)rintf(v[4 * q + 1] * qs), q2 = (int)rintf(v[4 * q + 2] * qs), q3 = (int)rintf(v[4 * q + 3] * qs);
            o[q] = ((unsigned)q0 & 255u) | (((unsigned)q1 & 255u) << 8) | (((unsigned)q2 & 255u) << 16) | (((unsigned)q3 & 255u) << 24);
        }
        *(u32x4*)(ws + WS_X8T + (tok0 + t) * 1024 + lane * 16) = (u32x4){o[0], o[1], o[2], o[3]};
        if (lane == 0) ((float*)(ws + WS_QF))[tok0 + t] = rs * am * (1.f / 127.f);
    }
}

#define XB_TMO      128
#define XB_XCNT(j)  (256  + 64 * (j))
#define XB_XSUB(j)  (1280 + 64 * (j))
#define XB_XGEN(j)  (2304 + 64 * (j))
#define XB_TOP      3328
#define XB_TOPGEN   3392
#define XCD_BAR_WORDS 3456
#define XB_SPIN_CAP (1u << 18)
#define LAS __attribute__((address_space(3)))
DEVFI unsigned xb_ld(unsigned* p)              { return __hip_atomic_load(p, __ATOMIC_RELAXED, __HIP_MEMORY_SCOPE_AGENT); }
DEVFI unsigned xb_add(unsigned* p, unsigned v) { return __hip_atomic_fetch_add(p, v, __ATOMIC_RELAXED, __HIP_MEMORY_SCOPE_AGENT); }
DEVFI unsigned xb_xcc_id() { return (unsigned)__builtin_amdgcn_s_getreg((3 << 11) | 20) & 0xFu; }
#define XB_SPIN(cond, bar) do { unsigned _sp = 0; while (cond) { __builtin_amdgcn_s_sleep(1); \
    if ((++_sp & 255u) == 0u) { if (xb_ld(&(bar)[XB_TMO])) break; if (_sp > XB_SPIN_CAP) { atomicAdd(&(bar)[XB_TMO], 1u); break; } } } } while (0)
struct XcdBarrier { unsigned* bar; unsigned x; volatile LAS unsigned* st; };
DEVFI XcdBarrier xcd_barrier_post(unsigned* bar, volatile LAS unsigned* st) {
    XcdBarrier b; b.bar = bar; b.x = xb_xcc_id(); b.st = st;
    if (threadIdx.x == 0) (void)xb_add(&bar[XB_XCNT(b.x)], 1u);
    return b;
}
DEVFI void xcd_barrier_complete(unsigned* bar, unsigned x, unsigned& nloc, unsigned& nx) {
    const unsigned G = gridDim.x * gridDim.y * gridDim.z;
    unsigned sum, cnt, mine, sp = 0u;
    for (;;) {
        sum = 0u; cnt = 0u; mine = 0u;
#pragma unroll
        for (unsigned j = 0; j < 16; ++j) { const unsigned c = xb_ld(&bar[XB_XCNT(j)]); sum += c; cnt += (c > 0u) ? 1u : 0u; mine = (j == x) ? c : mine; }
        if (sum == G) break;
        __builtin_amdgcn_s_sleep(1);
        if ((++sp & 255u) == 0u) { if (xb_ld(&bar[XB_TMO])) break; if (sp > XB_SPIN_CAP) { atomicAdd(&bar[XB_TMO], 1u); break; } }
    }
    nloc = mine > 0u ? mine : 1u; nx = cnt > 0u ? cnt : 1u;
}
DEVFI void xcd_barrier(const XcdBarrier& b) {
    asm volatile("s_waitcnt vmcnt(0)" ::: "memory");
    __syncthreads();
    if (threadIdx.x == 0) {
        unsigned* bar = b.bar;
        __builtin_amdgcn_s_waitcnt(0);
        unsigned nloc = b.st[0], nx = b.st[1];
        if (nloc == 0u) { xcd_barrier_complete(bar, b.x, nloc, nx); b.st[0] = nloc; b.st[1] = nx; }
        const unsigned old = xb_add(&bar[XB_XSUB(b.x)], 1u);
        const unsigned gen = old / nloc;
        if (old + 1u == (gen + 1u) * nloc) {
            __builtin_amdgcn_fence(__ATOMIC_RELEASE, "agent");
            asm volatile("s_waitcnt vmcnt(0)" ::: "memory");
            const unsigned og = xb_add(&bar[XB_TOP], 1u);
            const unsigned tg = og / nx;
            if (og + 1u == (tg + 1u) * nx) xb_add(&bar[XB_TOPGEN], 1u);
            else XB_SPIN(xb_ld(&bar[XB_TOPGEN]) == tg, bar);
            __builtin_amdgcn_fence(__ATOMIC_ACQUIRE, "agent");
            xb_add(&bar[XB_XGEN(b.x)], 1u);
            asm volatile("s_waitcnt vmcnt(0)" ::: "memory");
        } else {
            XB_SPIN(xb_ld(&bar[XB_XGEN(b.x)]) == gen, bar);
            __builtin_amdgcn_fence(__ATOMIC_ACQUIRE, "agent");
            asm volatile("s_waitcnt vmcnt(0)" ::: "memory");
        }
    }
    __syncthreads();
}

__global__ void __launch_bounds__(NTHR, 2) hymba_fwd(Params P) {
    extern __shared__ __attribute__((aligned(16))) unsigned char smem[];
    cg::grid_group grid = cg::this_grid();
    const int bid = blockIdx.x, nb = gridDim.x, tid = threadIdx.x;
    unsigned char* ws = P.ws;
    const int lo = P.ph_lo, hi = P.ph_hi;
#define IN_PH(k) (lo <= (k) && (k) < hi)
    volatile LAS unsigned* xb_st = (volatile LAS unsigned*)((LAS unsigned char*)smem + (LDS_BYTES - 32));
    if (tid == 0) { xb_st[0] = 0u; xb_st[1] = 0u; }
    __syncthreads();
    const XcdBarrier xbar = xcd_barrier_post((unsigned*)(ws + WS_CTL + 16384), xb_st);
#define SEAM(k) do { if (IN_PH(k) && IN_PH((k) + 1)) { if ((k) == 0) grid.sync(); else xcd_barrier(xbar); } } while (0)
    volatile unsigned* xq_slot = (volatile unsigned*)(smem + LDS_BYTES - 16);
    const unsigned xq_my = xb_xcc_id() & 7u;
#define XQ_FETCH(ctr_, dst_) do { if (tid == 0) *xq_slot = atomicAdd((ctr_), 1u); __syncthreads(); dst_ = *xq_slot; __syncthreads(); } while (0)

    if (IN_PH(0)) for (int rep_ = 0; rep_ < (PROBE_PHASE == 0 ? 2 : 1); ++rep_) { if (rep_) xcd_barrier(xbar); phase0(P, smem); }
    SEAM(0);
    if (IN_PH(1)) for (int rep_ = 0; rep_ < (PROBE_PHASE == 1 ? 2 : 1); ++rep_) {
        if (rep_) xcd_barrier(xbar);
#if DO_ATTN
        {
            unsigned* cbase = (unsigned*)(ws + WS_CTL) + 512 + rep_ * 128;
#pragma unroll 1
            for (unsigned att = 0; att < 8u; ++att) {
                const unsigned q = (xq_my + att) & 7u;
#pragma unroll 1
                for (;;) {
                    unsigned i; XQ_FETCH(cbase + q * 16, i);
                    if (i >= 768u) break;
                    const unsigned mtg = i / 192u, r = i % 192u, ntc = r >> 6, j = r & 63u;
                    const int mt = (int)(32u * q + mtg * 8u + (j & 7u)), nt = (int)(ntc * 8u + (j >> 3));
                    if (nt >= 23) continue;
                    EpiInProj epi; epi.m0 = mt * 256; epi.nt = nt; epi.ws = ws; epi.dt_bias = P.in[13]; epi.stage = smem;
                    gemm_tile3_i8<2, 4>(ws + WS_XN + (size_t)mt * 256 * 1024, 1024, ws + WS_WIN + (size_t)nt * 128 * 1024, 1024, (PROBE_PHASE == 1 && PROBE_VARIANT == 1 && rep_ == 0) ? 1 : 16,
                                        (const float*)(ws + WS_SXN) + mt * 256, (const float*)(ws + WS_SW) + nt * 128, smem, epi);
                    __syncthreads();
                }
            }
        }
#endif
    }
    SEAM(1);
    if (IN_PH(2)) for (int rep_ = 0; rep_ < (PROBE_PHASE == 2 ? 2 : 1); ++rep_) {
        if (rep_) xcd_barrier(xbar);
#if DO_ATTN && DO_NSA
        for (int item = bid; item < 256; item += nb) compress_item(P, item, smem);
#endif
#if DO_PEER
        if (rep_ == 0) { for (int row = bid * 4 + (tid >> 6); row < 2048; row += nb * 4) wq_quant_row(ws, row, tid & 63); }
#endif
#if DO_ATTN && DO_SSD
        {
            unsigned* cq = (unsigned*)(ws + WS_CTL) + 1792 + rep_ * 16;
#pragma unroll 1
            for (;;) {
                unsigned i; XQ_FETCH(cq, i);
                if (i >= 1024u) break;
                conv_item(P, (int)(2u * i));
                conv_item(P, (int)(2u * i + 1u));
            }
        }
#endif
    }
    SEAM(2);
    if (IN_PH(3)) for (int rep_ = 0; rep_ < ((PROBE_PHASE == 3 || PROBE_PHASE == 31 || PROBE_PHASE == 32) ? 2 : 1); ++rep_) {
        if (rep_) xcd_barrier(xbar);
#if DO_ATTN
        unsigned* ctr0 = (unsigned*)(ws + WS_CTL) + rep_ * 8 * 16;
        volatile unsigned* s_item = (volatile unsigned*)(smem + LDS_BYTES - 16);
        const unsigned myq = xb_xcc_id() & 7u;
        const unsigned lim_lo = (rep_ == 1 && PROBE_PHASE == 32) ? 16u : 0u;
        const unsigned lim_hi = (rep_ == 1 && PROBE_PHASE == 31) ? 16u : 272u;
#define FETCH_ITEM(dst) do { if (tid == 0) *s_item = atomicAdd(ctr, 1u); __syncthreads(); dst = *s_item + lim_lo; __syncthreads(); } while (0)
#pragma unroll 1
        for (unsigned att = 0; att < 8u; ++att) {
            const unsigned q = (myq + att) & 7u;
            unsigned* ctr = ctr0 + q * 16;
            unsigned item;
            FETCH_ITEM(item);
#pragma unroll 1
            while (item < 16u) {
                const unsigned sid = q * 16u + item;
#if DO_SSD
                ssd_item(P, sid >> 3, sid & 7, smem);
#else
                {
                    const int b = sid >> 3, hd = sid & 7;
                    for (int i = tid; i < 4096 * 8; i += NTHR) {
                        const size_t tk = (size_t)b * 4096 + (i >> 3);
                        *(u32x4*)((bf16_t*)(ws + WS_AMAT) + tk * 1024 + 512 + hd * 64 + (i & 7) * 8) = (u32x4){0u, 0u, 0u, 0u};
                        if ((i & 7) < 2) ((float*)(ws + WS_SSS))[tk * 16 + hd * 2 + (i & 7)] = 0.f;
                    }
                }
#endif
                FETCH_ITEM(item);
            }
#pragma unroll 1
            while (item < lim_hi) {
                const int j = (int)item - 16;
                const int qb = 63 - (j & 63), bg = (int)q + 8 * (j >> 6);
#if DO_NSA
                nsa_item(P, bg, qb, smem, (rep_ == 1 && PROBE_PHASE == 32) ? PROBE_VARIANT : 0);
#else
                {
                    const int b = bg >> 1, g = bg & 1;
                    for (int i = tid; i < 64 * 32; i += NTHR) {
                        const size_t tk = (size_t)b * 4096 + qb * 64 + (i >> 5);
                        *(u32x4*)((bf16_t*)(ws + WS_AMAT) + tk * 1024 + g * 256 + (i & 31) * 8) = (u32x4){0u, 0u, 0u, 0u};
                        if ((i & 31) < 4) ((float*)(ws + WS_SSN))[tk * 8 + g * 4 + (i & 31)] = 0.f;
                    }
                }
#endif
                FETCH_ITEM(item);
            }
        }
#undef FETCH_ITEM
#endif
    }
    SEAM(3);
    if (IN_PH(4)) for (int rep_ = 0; rep_ < (PROBE_PHASE == 4 ? 2 : 1); ++rep_) {
        if (rep_) xcd_barrier(xbar);
#if DO_ATTN
        {
            unsigned* cbase = (unsigned*)(ws + WS_CTL) + 768 + rep_ * 128;
#pragma unroll 1
            for (unsigned att = 0; att < 8u; ++att) {
                const unsigned q = (xq_my + att) & 7u;
#pragma unroll 1
                for (;;) {
                    unsigned i; XQ_FETCH(cbase + q * 16, i);
                    if (i >= 256u) break;
                    const int mt = (int)(32u * q + (i >> 6) * 8u + (i & 7u)), nt = (int)((i >> 3) & 7u);
                    EpiOutProj<4> epi; epi.m0 = mt * 256; epi.n0 = nt * 128; epi.x = P.in[0]; epi.x1 = P.out; epi.xq8 = ws + WS_XN; epi.xsc = (const float*)(ws + WS_SXR);
                    epi.x1b = (bf16_t*)(ws + WS_X1B); epi.ssx = (float*)(ws + WS_SSX); epi.stage = smem; epi.x8 = ws + WS_X8; epi.sx = (float*)(ws + WS_SX);
                    epi.init(ws, (tid >> 6) >> 1, tid & 63);
                    gemm_tile3<2, 4, true>((const bf16_t*)(ws + WS_AMAT) + (size_t)mt * 256 * 1024, 1024,
                                           (const bf16_t*)(ws + WS_WOUT) + (size_t)nt * 128 * 1024, 1024, (PROBE_PHASE == 4 && PROBE_VARIANT == 1 && rep_ == 0) ? 1 : 16, smem, epi);
                    __syncthreads();
                }
            }
        }
#else
        copy_x1(P);
#endif
    }
#if DO_PEER && DO_ATTN
    if (IN_PH(4)) {
        xcd_barrier(xbar);
        size_t zoff_ = 0; asm volatile("" : "+s"(zoff_)); unsigned char* wsl = P.ws + zoff_;
        const int lane = tid & 63, w = tid >> 6;
        for (size_t tok = ((size_t)bid * 4 + w) * 4; tok < (size_t)T; tok += (size_t)nb * 16) x1_requant_tokens4(wsl, tok, lane);
    }
#endif
    SEAM(4);
    if (IN_PH(5)) for (int rep_ = 0; rep_ < (PROBE_PHASE == 5 ? 2 : 1); ++rep_) {
        if (rep_) xcd_barrier(xbar);
#if DO_PEER
        {
            unsigned* cbase = (unsigned*)(ws + WS_CTL) + 1024 + rep_ * 128;
#pragma unroll 1
            for (unsigned att = 0; att < 8u; ++att) {
                const unsigned q = (xq_my + att) & 7u;
#pragma unroll 1
                for (;;) {
                    unsigned i; XQ_FETCH(cbase + q * 16, i);
                    if (i >= 512u) break;
                    const unsigned g6 = i >> 6, j = i & 63u;
                    const int mt = (int)(64u * q + (g6 >> 1) * 16u + (j & 15u)), hh = (int)((g6 & 1u) * 4u + (j >> 4));
                    peer_route_item(P, (PROBE_PHASE == 5 && PROBE_VARIANT == 2 && rep_ == 0) ? 0 : mt * 8 + hh, smem, (int)(((j >> 4) * 4u + (j & 15u)) & 15u), (PROBE_PHASE == 5 && PROBE_VARIANT == 1 && rep_ == 0) ? 1 : 16);
                    __syncthreads();
                }
            }
        }
#endif
    }
    SEAM(5);
    if (IN_PH(6)) for (int rep_ = 0; rep_ < (PROBE_PHASE == 6 ? 2 : 1); ++rep_) {
        if (rep_) xcd_barrier(xbar);
#if DO_PEER
        size_t zoff_ = 0; asm volatile("" : "+s"(zoff_)); unsigned char* wsl = P.ws + zoff_;
        unsigned* cbase = (unsigned*)(wsl + WS_CTL) + 1280 + rep_ * 128;
        const int lane = tid & 63, w = tid >> 6;
#pragma unroll 1
        for (unsigned att = 0; att < 8u; ++att) {
            const unsigned q = (xq_my + att) & 7u;
#pragma unroll 1
            for (;;) {
                unsigned i; XQ_FETCH(cbase + q * 16, i);
                if (i >= 512u) break;
                const size_t t0 = (size_t)(q >> 2) * 32768 + (size_t)i * 64 + w * 16;
                peer_u_task(wsl, t0, (int)q, lane, (int*)smem + w * 2048);
                peer_u_task(wsl, t0 + 8, (int)q, lane, (int*)smem + w * 2048);
            }
        }
#endif
    }
    SEAM(6);
    if (IN_PH(7)) {
#if DO_PEER
        size_t zoff_ = 0; asm volatile("" : "+s"(zoff_)); unsigned char* wsl = P.ws + zoff_;
        const int lane = tid & 63, w = tid >> 6;
        for (size_t tok = ((size_t)bid * 4 + w) * 4; tok < (size_t)T; tok += (size_t)nb * 16) peer_c_tokens4(wsl, tok, lane);
#endif
    }
    SEAM(7);
    if (IN_PH(8)) for (int rep_ = 0; rep_ < (PROBE_PHASE == 8 ? 2 : 1); ++rep_) {
        if (rep_) xcd_barrier(xbar);
#if DO_PEER
        size_t zoff_ = 0; asm volatile("" : "+s"(zoff_)); unsigned char* wsl = P.ws + zoff_;
        unsigned* cbase = (unsigned*)(wsl + WS_CTL) + 1536 + rep_ * 128;
        const bool dry = (PROBE_PHASE == 8) && rep_ == 0;
        const int lane = tid & 63, w = tid >> 6;
#pragma unroll 1
        for (unsigned att = 0; att < 8u; ++att) {
            const unsigned q = (xq_my + att) & 7u;
#pragma unroll 1
            for (;;) {
                unsigned i; XQ_FETCH(cbase + q * 16, i);
                if (i >= 512u) break;
                const size_t t0 = (size_t)(q >> 2) * 32768 + (size_t)i * 64 + w * 16;
                peer_v_task(P, wsl, t0, (int)q, lane, dry, (int*)smem + w * 2048);
                peer_v_task(P, wsl, t0 + 8, (int)q, lane, dry, (int*)smem + w * 2048);
            }
        }
#endif
    }
    SEAM(8);
    if (IN_PH(9)) {
        const int lane = tid & 63, w = tid >> 6;
        for (size_t tok = ((size_t)bid * 4 + w) * 4; tok < (size_t)T; tok += (size_t)nb * 16) final_norm_tokens4(P, tok, lane);
    }
}

extern "C" void kernel_launch(void* const* d_in, const int* in_sizes, int n_in, void* d_out, int out_size, void* d_ws, size_t ws_size,
                              hipStream_t stream) {
    static int grid_blocks = 0;
    if (grid_blocks == 0) {
        if (n_in != 25 || out_size != T * D || ws_size < WS_END) {
            fprintf(stderr, "kernel_launch: unexpected shapes (n_in %d, out %d, ws %zu < %zu)\n", n_in, out_size, ws_size, (size_t)WS_END);
            grid_blocks = -1;
            return;
        }
        int dev = 0, cus = 0, per_cu = 0;
        hipGetDevice(&dev);
        hipDeviceGetAttribute(&cus, hipDeviceAttributeMultiprocessorCount, dev);
        hipFuncSetAttribute((const void*)hymba_fwd, hipFuncAttributeMaxDynamicSharedMemorySize, LDS_BYTES);
        hipOccupancyMaxActiveBlocksPerMultiprocessor(&per_cu, (const void*)hymba_fwd, NTHR, LDS_BYTES);
        if (per_cu < 1) per_cu = 1;
        if (per_cu > 2) per_cu = 2;
        grid_blocks = cus * per_cu;
        fprintf(stderr, "kernel_launch: %d CUs x %d blocks\n", cus, per_cu);
    }
    if (grid_blocks < 0) return;
    (void)hipMemsetAsync((char*)d_ws + WS_CTL, 0, 32768, stream);
    Params p{};
    for (int i = 0; i < 25; ++i) p.in[i] = (const float*)d_in[i];
    p.out = (float*)d_out;
    p.ws = (unsigned char*)d_ws;
#if N_LAUNCH_SPLIT
    for (int ph = 0; ph < 10; ++ph) {
        p.ph_lo = ph; p.ph_hi = ph + 1;
        void* args[] = {&p};
        hipLaunchCooperativeKernel((void*)hymba_fwd, dim3(grid_blocks), dim3(NTHR), args, LDS_BYTES, stream);
    }
#else
    p.ph_lo = 0; p.ph_hi = 10;
    void* args[] = {&p};
    hipError_t e = hipLaunchCooperativeKernel((void*)hymba_fwd, dim3(grid_blocks), dim3(NTHR), args, LDS_BYTES, stream);
    if (e != hipSuccess) fprintf(stderr, "cooperative launch failed: %s (grid %d)\n", hipGetErrorString(e), grid_blocks);
#endif
}
```
